# Optimizing an MI355X kernel written in HIP

```python
import jax, jax.numpy as jnp
from jax import lax
import numpy as np


D_MODEL = 1024
BATCH = 16
SEQ = 256
DEPTH = 2
DEC_BATCH = 2
DEC_SEQ = 2048
PAST_LEN = 512

GRID_W = 64
EXPAND = 2
D_MIX = EXPAND * D_MODEL
D_SSD = D_MIX // 2
D_CONF = D_MIX - D_SSD
SSD_HEAD_DIM = 64
SSD_HEADS = D_SSD // SSD_HEAD_DIM
SSD_GROUPS = 2
HEADS_PER_GROUP = SSD_HEADS // SSD_GROUPS
D_STATE = 128
SSD_CONV_W = 5
SSD_CONV_CH = D_SSD + 2 * SSD_GROUPS * D_STATE
CHUNK = 128
N_DIR = 2
CONF_CONV_W = 31
EPS = 1e-6

I_Z = D_SSD
I_XBC = I_Z + SSD_CONV_CH
I_DT = I_XBC + N_DIR * SSD_HEADS
I_GA = I_DT + D_CONF
I_GB = I_GA + D_CONF
IN_COLS = I_GB + D_CONF

kernel_name = "hybrid_ssd_conformer_diffusion_step"


def rms_norm(x, g):
    xf = x.astype(jnp.float32)
    y = xf * lax.rsqrt(jnp.mean(xf * xf, axis=-1, keepdims=True) + EPS)
    return (y * g.astype(jnp.float32)).astype(x.dtype)


def layer_norm(x, g, b):
    xf = x.astype(jnp.float32)
    mu = jnp.mean(xf, axis=-1, keepdims=True)
    var = jnp.mean(jnp.square(xf - mu), axis=-1, keepdims=True)
    y = (xf - mu) * lax.rsqrt(var + EPS)
    return (y * g.astype(jnp.float32) + b.astype(jnp.float32)).astype(x.dtype)


def depthwise_conv(x, w, b):
    k, ch = w.shape
    out = lax.conv_general_dilated(
        x, w.reshape(k, 1, 1, ch).astype(x.dtype), window_strides=(1, 1),
        padding=((k // 2, k // 2), (0, 0)),
        dimension_numbers=('NHWC', 'HWIO', 'NHWC'), feature_group_count=ch)
    return out + b.astype(x.dtype)


def segsum(a):
    t = a.shape[-1]
    idx = jnp.arange(t)
    xr = jnp.where(idx[:, None] > idx[None, :], a[..., :, None], 0.0)
    s = jnp.cumsum(xr, axis=-2)
    return jnp.where(idx[:, None] >= idx[None, :], s, -jnp.inf)


def ssd_scan(x, dt, a, b_in, c_in, h0):
    bsz, seqlen = x.shape[:2]
    nc = seqlen // CHUNK
    g, r, p, n = SSD_GROUPS, HEADS_PER_GROUP, SSD_HEAD_DIM, D_STATE
    xg = (x * dt[..., None]).reshape(bsz, nc, CHUNK, g, r, p)
    la = (dt * a).reshape(bsz, nc, CHUNK, g, r).transpose(0, 3, 4, 1, 2)
    bc = b_in.reshape(bsz, nc, CHUNK, g, n)
    cc = c_in.reshape(bsz, nc, CHUNK, g, n)
    la_cum = jnp.cumsum(la, axis=-1)
    decay_in = jnp.exp(segsum(la))
    cb = jnp.einsum('bclgn,bcsgn->bgcls', cc, bc)
    y_diag = jnp.einsum('bgcls,bgrcls,bcsgrp->bclgrp', cb, decay_in, xg)
    decay_to_end = jnp.exp(la_cum[..., -1:] - la_cum)
    states = jnp.einsum('bclgn,bgrcl,bclgrp->bcgrpn', bc, decay_to_end, xg)
    h0g = h0.astype(jnp.float32).reshape(bsz, 1, g, r, p, n)
    states = jnp.concatenate([h0g, states], axis=1)
    chunk_tot = jnp.pad(la_cum[..., -1], ((0, 0), (0, 0), (0, 0), (1, 0)))
    decay_chunk = jnp.exp(segsum(chunk_tot))
    states = jnp.einsum('bgrzc,bcgrpn->bzgrpn', decay_chunk, states)
    prev, final = states[:, :-1], states[:, -1]
    y_off = jnp.einsum('bclgn,bcgrpn,bgrcl->bclgrp', cc, prev, jnp.exp(la_cum))
    y = (y_diag + y_off).reshape(bsz, seqlen, SSD_HEADS, p)
    return y, final.reshape(bsz, SSD_HEADS, p, n)


def ssd_branch(z, xbc, dt_raw, conv_w, conv_b, a_log, dt_bias, d_skip, norm_g, h0):
    bsz, seqlen, _ = xbc.shape
    xbc = jax.nn.silu(depthwise_conv(xbc[:, :, None, :], conv_w, conv_b)[:, :, 0, :])
    xs, b_in, c_in = jnp.split(xbc.astype(jnp.float32), [D_SSD, D_SSD + SSD_GROUPS * D_STATE], axis=-1)
    xs = xs.reshape(bsz, seqlen, SSD_HEADS, SSD_HEAD_DIM)
    b_in = b_in.reshape(bsz, seqlen, SSD_GROUPS, D_STATE)
    c_in = c_in.reshape(bsz, seqlen, SSD_GROUPS, D_STATE)
    dt = jax.nn.softplus(dt_raw.astype(jnp.float32).reshape(bsz, seqlen, N_DIR, SSD_HEADS)
                         + dt_bias.astype(jnp.float32))
    a = -jnp.exp(a_log.astype(jnp.float32))
    y_f, h_f = ssd_scan(xs, dt[:, :, 0], a[0], b_in, c_in, h0[:, 0])
    y_b, h_b = ssd_scan(jnp.flip(xs, 1), jnp.flip(dt[:, :, 1], 1), a[1],
                        jnp.flip(b_in, 1), jnp.flip(c_in, 1), h0[:, 1])
    y = y_f + jnp.flip(y_b, 1) + d_skip.astype(jnp.float32)[:, None] * xs
    y = y.reshape(bsz, seqlen, D_SSD) * jax.nn.silu(z.astype(jnp.float32))
    y = rms_norm(y, norm_g)
    return y.astype(z.dtype), jnp.stack([h_f, h_b], axis=1)


def conformer_branch(ga, gb, conv_w, conv_b, ln_g, ln_b):
    h = ga * jax.nn.sigmoid(gb)
    h = depthwise_conv(h, conv_w, conv_b)
    h = layer_norm(h, ln_g, ln_b)
    return jax.nn.silu(h)


def trunk_layer(x, mod, grid, h0, g_pre, g_post, w_in, ssd_conv_w, ssd_conv_b, a_log, dt_bias,
                d_skip, ssd_norm_g, conf_conv_w, conf_conv_b, conf_ln_g, conf_ln_b, w_out):
    bsz, seqlen, _ = x.shape
    shift, scale, gate = jnp.split(mod[:, None, :].astype(x.dtype), 3, axis=-1)
    h = rms_norm(x, g_pre) * (1 + scale) + shift
    u = h @ w_in
    z, xbc, dt_raw, ga, gb, gsil = jnp.split(u, [I_Z, I_XBC, I_DT, I_GA, I_GB], axis=-1)
    y_ssd, h_fin = ssd_branch(z, xbc, dt_raw, ssd_conv_w, ssd_conv_b, a_log, dt_bias, d_skip,
                              ssd_norm_g, h0)
    rows, cols = grid
    y_conf = conformer_branch(ga.reshape(bsz, rows, cols, D_CONF), gb.reshape(bsz, rows, cols, D_CONF),
                              conf_conv_w, conf_conv_b, conf_ln_g, conf_ln_b)
    y_conf = y_conf.reshape(bsz, seqlen, D_CONF) * jax.nn.silu(gsil)
    out = jnp.concatenate([y_ssd.astype(x.dtype), y_conf.astype(x.dtype)], axis=-1) @ w_out
    return x + gate * rms_norm(out, g_post), h_fin


def setup_inputs(seed: int = 0) -> dict:
    key = jax.random.key(seed)
    ks = jax.random.split(key, 24)
    f32 = jnp.float32
    nrm = lambda k, shape, s: jax.random.normal(k, shape, f32) * s
    dt0 = jnp.exp(jax.random.uniform(ks[12], (DEPTH, N_DIR, SSD_HEADS), f32,
                                     np.log(1e-3).astype(np.float32), np.log(1e-1).astype(np.float32)))
    return {
        "x_prompt": nrm(ks[0], (BATCH, SEQ, D_MODEL), 1.0),
        "x_sample": nrm(ks[1], (DEC_BATCH, DEC_SEQ, D_MODEL), 1.0),
        "state_ssd": nrm(ks[2], (DEC_BATCH, DEPTH, N_DIR, SSD_HEADS, SSD_HEAD_DIM, D_STATE), 0.1),
        "c": nrm(ks[3], (DEC_BATCH, D_MODEL), 1.0),
        "c_ctx": nrm(ks[4], (D_MODEL,), 1.0),
        "w_mod": nrm(ks[5], (DEPTH, D_MODEL, 3 * D_MODEL), 0.2 * D_MODEL ** -0.5),
        "b_mod": nrm(ks[6], (DEPTH, 3 * D_MODEL), 0.02),
        "g_pre": 1.0 + nrm(ks[7], (DEPTH, D_MODEL), 0.1),
        "g_post": 1.0 + nrm(ks[8], (DEPTH, D_MODEL), 0.1),
        "w_in": nrm(ks[9], (DEPTH, D_MODEL, IN_COLS), D_MODEL ** -0.5),
        "ssd_conv_w": nrm(ks[10], (DEPTH, SSD_CONV_W, SSD_CONV_CH), SSD_CONV_W ** -0.5),
        "ssd_conv_b": nrm(ks[11], (DEPTH, SSD_CONV_CH), 0.01),
        "ssd_a_log": jnp.log(jax.random.uniform(ks[13], (DEPTH, N_DIR, SSD_HEADS), f32, 1.0, 16.0)),
        "ssd_dt_bias": dt0 + jnp.log(-jnp.expm1(-dt0)),
        "ssd_d": 1.0 + nrm(ks[14], (DEPTH, SSD_HEADS), 0.1),
        "ssd_norm_g": 1.0 + nrm(ks[15], (DEPTH, D_SSD), 0.1),
        "conf_conv_w": nrm(ks[16], (DEPTH, CONF_CONV_W, D_CONF), CONF_CONV_W ** -0.5),
        "conf_conv_b": nrm(ks[17], (DEPTH, D_CONF), 0.01),
        "conf_ln_g": 1.0 + nrm(ks[18], (DEPTH, D_CONF), 0.1),
        "conf_ln_b": nrm(ks[19], (DEPTH, D_CONF), 0.01),
        "w_out": nrm(ks[20], (DEPTH, D_MIX, D_MODEL), D_MIX ** -0.5),
    }


def reference(x_prompt, x_sample, state_ssd, c, c_ctx, w_mod, b_mod, g_pre, g_post, w_in,
              ssd_conv_w, ssd_conv_b, ssd_a_log, ssd_dt_bias, ssd_d, ssd_norm_g,
              conf_conv_w, conf_conv_b, conf_ln_g, conf_ln_b, w_out):
    ctx_b, ctx_len = x_prompt.shape[0], x_prompt.shape[1]
    rows = x_sample.shape[1] // GRID_W
    ctx_grid = (ctx_len, 1)
    lat_grid = (rows, GRID_W)
    silu_ctx = jax.nn.silu(c_ctx)[None, :]
    silu_c = jax.nn.silu(c)
    h0_ctx = jnp.zeros((ctx_b, N_DIR, SSD_HEADS, SSD_HEAD_DIM, D_STATE), jnp.float32)
    xp, xs = x_prompt, x_sample
    ctx_states = []
    for l in range(DEPTH):
        lp = (g_pre[l], g_post[l], w_in[l], ssd_conv_w[l], ssd_conv_b[l], ssd_a_log[l], ssd_dt_bias[l],
              ssd_d[l], ssd_norm_g[l], conf_conv_w[l], conf_conv_b[l], conf_ln_g[l], conf_ln_b[l], w_out[l])
        mod_ctx = silu_ctx @ w_mod[l] + b_mod[l]
        xp, st = trunk_layer(xp, mod_ctx, ctx_grid, h0_ctx, *lp)
        ctx_states.append(st.astype(x_prompt.dtype))
        mod_lat = silu_c @ w_mod[l] + b_mod[l]
        xs, _ = trunk_layer(xs, mod_lat, lat_grid, state_ssd[:, l], *lp)
    new_state_ssd = jnp.stack(ctx_states, axis=1)
    return (xp, xs, new_state_ssd)
```

```cpp
#include <hip/hip_runtime.h>
#include <hip/hip_cooperative_groups.h>
#include <cstdio>
namespace cg = cooperative_groups;
#ifndef REP_GEMM
#define REP_GEMM 1
#endif
#ifndef REP_SYNC
#define REP_SYNC 1
#endif
#ifndef REP_SSD
#define REP_SSD 1
#endif
#ifndef REP_MISC
#define REP_MISC 1
#endif

#define LAS __attribute__((address_space(3)))
typedef unsigned short bf16_t;
typedef short bf16x8 __attribute__((ext_vector_type(8)));
typedef float f32x4 __attribute__((ext_vector_type(4)));
typedef float f32x2 __attribute__((ext_vector_type(2)));
typedef unsigned u32x4 __attribute__((ext_vector_type(4)));
typedef unsigned u32x2 __attribute__((ext_vector_type(2)));

constexpr int DM = 1024, NTOK = 8192, NCTXTOK = 4096;
constexpr int UC = 5632;
constexpr int NIN = 5888;
constexpr int INCOLS = 5664;
constexpr int U_Z = 0, U_X = 1024, U_B = 2048, U_C = 2176, U_GA = 2560, U_GB = 3584, U_GS = 4608;
constexpr float EPSF = 1e-6f;
constexpr unsigned U_PSTRIDE = 8192u * 512u + 36864u;
__host__ __device__ __forceinline__ unsigned uoff(unsigned row, unsigned col) { return (col >> 8) * U_PSTRIDE + row * 512u + (col & 255u) * 2u; }
constexpr size_t MiB = 1u << 20;
constexpr size_t WS_MOD = 0, WS_TOT = 256 * 1024, WS_SSQ = 512 * 1024;
constexpr size_t WS_WIN = 1 * MiB, WIN_BYTES = (size_t)NIN * 1024 * 2;
constexpr size_t WS_WOUT = 24 * MiB, WOUT_BYTES = (size_t)2048 * 1024 * 2;
constexpr size_t WS_H = 32 * MiB, WS_U = 48 * MiB, WS_OUT = 48 * MiB, WS_DT = 250 * MiB, WS_YS = 137 * MiB, WS_YC = 153 * MiB, WS_ST = 169 * MiB;
constexpr size_t WS_SINL = 32 * MiB  , WS_SINC = 234 * MiB;
constexpr int LDS_BYTES = 155648;

struct Args {
    const float *x_prompt, *x_sample, *state_ssd, *c, *c_ctx, *w_mod, *b_mod, *g_pre, *g_post, *w_in, *ssd_conv_w, *ssd_conv_b, *a_log, *dt_bias, *ssd_d, *ssd_norm_g,
        *conf_conv_w, *conf_conv_b, *conf_ln_g, *conf_ln_b, *w_out;
    float* out; unsigned char* ws;
};

__device__ __forceinline__ int ltid() { int t = (int)threadIdx.x; asm volatile("" : "+v"(t)); return t; }
typedef __bf16 bf16x2v __attribute__((ext_vector_type(2)));
__device__ __forceinline__ unsigned cvt_pk_bf16(float lo, float hi) { const f32x2 v = {lo, hi}; const bf16x2v b = __builtin_convertvector(v, bf16x2v); return __builtin_bit_cast(unsigned, b); }
__device__ __forceinline__ float bf_lo(unsigned w) { return __uint_as_float(w << 16); }
__device__ __forceinline__ float bf_hi(unsigned w) { return __uint_as_float(w & 0xffff0000u); }
__device__ __forceinline__ float silu_f(float v) { return v * __builtin_amdgcn_rcpf(1.f + __expf(-v)); }
__device__ __forceinline__ float sigmoid_f(float v) { return __builtin_amdgcn_rcpf(1.f + __expf(-v)); }
__device__ __forceinline__ float softplus_f(float v) { return fmaxf(v, 0.f) + log1pf(__expf(-fabsf(v))); }
__device__ __forceinline__ float wave_sum(float v) {
#pragma unroll
    for (int o = 1; o < 64; o <<= 1) v += __shfl_xor(v, o);
    return v;
}

namespace pg8 {
constexpr int BM = 256, BK = 64, HALF = 128, HTB = HALF * BK * 2, STAGE_BYTES = 8 * HTB, NXCD = 8, WGM = 8;
__host__ __device__ __forceinline__ int lds_byte(int r, int c) { const int st = (r >> 4) * 2 + (c >> 5), rr = r & 15, cc = c & 31, ob = rr * 64 + cc * 2; return st * 1024 + (ob ^ (((ob >> 9) & 1) << 5)); }
__host__ __device__ __forceinline__ void stage_rc(int b, int& R, int& C) { const int st = b / 1024, sb = b % 1024, swz = sb ^ (((sb >> 9) & 1) << 5); R = (st >> 1) * 16 + swz / 64; C = (st & 1) * 32 + (swz % 64) / 2; }
__host__ __device__ __forceinline__ int perm32(int rho) { const int n = rho >> 4, i = rho & 15; return 8 * (i >> 2) + 4 * n + (i & 3); }
struct Unit { int pm, pn; };
struct Gemm { const bf16_t* A; const bf16_t* A2; const bf16_t* Bt; int M, N, K, split; };
struct StaticOrder {
    int nM, nN, nwg, G, c;
    __device__ void init(int M, int N, int G_, int c_) { nM = M / BM; nN = N / BM; nwg = nM * nN; G = G_; c = c_; }
    __device__ bool next(int i, Unit& u) const {
        const long L = (long)i * G + c; if (L >= nwg) return false;
        int wgid = (int)L; { const int q = nwg / NXCD, r = nwg % NXCD, xcd = wgid % NXCD, off = wgid / NXCD; wgid = (xcd < r ? xcd * (q + 1) : r * (q + 1) + (xcd - r) * q) + off; }
        const int nig = WGM * nN, gid = wgid / nig, fm = gid * WGM, gsz = (nM - fm) < WGM ? (nM - fm) : WGM;
        u.pm = fm + ((wgid % nig) % gsz); u.pn = (wgid % nig) / gsz; return true;
    }
};

struct EpiIn {
    static constexpr bool PERM = true;
    bf16_t* U; float* DT;
    __device__ __forceinline__ void operator()(const f32x4 (&acc)[2][2][4][2], const Unit& u, int wr, int wc, int fr, int fq) const {
        const int row0 = u.pm * BM + wr * 64 + fr;
        if (u.pn >= 10 && u.pn < 18) {
            const int col0 = U_GA + (u.pn - 10) * 128 + wc * 32 + 8 * fq;
#pragma unroll
            for (int ai = 0; ai < 2; ++ai)
#pragma unroll
                for (int m = 0; m < 4; ++m) { bf16_t* rowp = (bf16_t*)((char*)U + uoff((unsigned)(row0 + ai * HALF + m * 16), (unsigned)col0));
                    f32x4 v0, v1;
#pragma unroll
                    for (int e = 0; e < 4; ++e) { v0[e] = acc[ai][0][m][0][e] * sigmoid_f(acc[ai][1][m][0][e]); v1[e] = acc[ai][0][m][1][e] * sigmoid_f(acc[ai][1][m][1][e]); }
                    u32x4 w; w.x = cvt_pk_bf16(v0[0], v0[1]); w.y = cvt_pk_bf16(v0[2], v0[3]); w.z = cvt_pk_bf16(v1[0], v1[1]); w.w = cvt_pk_bf16(v1[2], v1[3]);
                    *(u32x4*)(rowp) = w; }
        } else if (u.pn < 22) {
            const bool act = (u.pn < 4) || (u.pn >= 18);
            const int col0 = (u.pn < 10 ? u.pn * BM : U_GS + (u.pn - 18) * BM) + wc * 32 + 8 * fq;
#pragma unroll
            for (int ai = 0; ai < 2; ++ai)
#pragma unroll
                for (int m = 0; m < 4; ++m) { bf16_t* rowp = (bf16_t*)((char*)U + uoff((unsigned)(row0 + ai * HALF + m * 16), (unsigned)col0));
#pragma unroll
                    for (int bj = 0; bj < 2; ++bj) { f32x4 v0 = acc[ai][bj][m][0], v1 = acc[ai][bj][m][1];
                        if (act) {
#pragma unroll
                            for (int e = 0; e < 4; ++e) { v0[e] = silu_f(v0[e]); v1[e] = silu_f(v1[e]); } }
                        u32x4 w; w.x = cvt_pk_bf16(v0[0], v0[1]); w.y = cvt_pk_bf16(v0[2], v0[3]); w.z = cvt_pk_bf16(v1[0], v1[1]); w.w = cvt_pk_bf16(v1[2], v1[3]);
                        *(u32x4*)(rowp + bj * HALF) = w; } }
        } else if (wc == 0) {
#pragma unroll
            for (int ai = 0; ai < 2; ++ai)
#pragma unroll
                for (int m = 0; m < 4; ++m) { float* rowp = DT + (size_t)(row0 + ai * HALF + m * 16) * 32 + 8 * fq;
                    *(f32x4*)(rowp) = acc[ai][0][m][0]; *(f32x4*)(rowp + 4) = acc[ai][0][m][1]; }
        }
    }
};
struct EpiOut {
    static constexpr bool PERM = true;
    bf16_t* O;
    __device__ __forceinline__ void operator()(const f32x4 (&acc)[2][2][4][2], const Unit& u, int wr, int wc, int fr, int fq) const {
        const int row0 = u.pm * BM + wr * 64 + fr, col0 = u.pn * BM + wc * 32 + 8 * fq;
#pragma unroll
        for (int ai = 0; ai < 2; ++ai)
#pragma unroll
            for (int m = 0; m < 4; ++m) { const int row = row0 + ai * HALF + m * 16;
                bf16_t* rowp = O + (size_t)row * 2048 + col0;
#pragma unroll
                for (int bj = 0; bj < 2; ++bj) { const f32x4 v0 = acc[ai][bj][m][0], v1 = acc[ai][bj][m][1];
                    u32x4 w; w.x = cvt_pk_bf16(v0[0], v0[1]); w.y = cvt_pk_bf16(v0[2], v0[3]); w.z = cvt_pk_bf16(v1[0], v1[1]); w.w = cvt_pk_bf16(v1[2], v1[3]);
                    *(u32x4*)(rowp + bj * HALF) = w; } }
    }
};

template <class Epi, class Sched>
__device__ __forceinline__ void gemm_phase(LAS unsigned char* lds, const Gemm g, const Sched& S, const Epi& E) {
    const int tid = ltid(), wid = __builtin_amdgcn_readfirstlane(tid >> 6), lane = tid & 63, wr = wid >> 2, wc = wid & 3, fr = lane & 15, fq = lane >> 4;
    const int K = g.K, nt = K / BK;
    unsigned voffA[2], voffB[2];
#pragma unroll
    for (int i = 0; i < 2; ++i) { int R, C; stage_rc(tid * 16 + i * 8192, R, C); const int Rb = Epi::PERM ? ((R & ~31) + perm32(R & 31)) : R;
        voffA[i] = (unsigned)(R * K + C) * 2u; voffB[i] = (unsigned)(Rb * K + C) * 2u; }
    const size_t kstep = (size_t)(BK * 2);
    const size_t hstep = (size_t)HALF * K * 2;
    const size_t tstep = 2 * hstep;
    const unsigned ldsw = (unsigned)wid * 1024u;
    const int aoff = lds_byte(wr * 64 + fr, fq * 8), boff = lds_byte(wc * 32 + fr, fq * 8);
#define PG8_SA(b, h) (((b) * 2 + (h)) * HTB)
#define PG8_SB(b, h) ((4 + (b) * 2 + (h)) * HTB)
#define PG8_STAGE(bufoff, gbase, voff) do { _Pragma("unroll") for (int _i = 0; _i < 2; ++_i) \
        __builtin_amdgcn_global_load_lds((const unsigned*)((const char*)(gbase) + (voff)[_i]), (LAS unsigned*)(lds + (bufoff) + ldsw + _i * 8192), 16, 0, 0); } while (0)
#define PG8_LDA(dst, b, h) do { _Pragma("unroll") for (int m = 0; m < 4; ++m) _Pragma("unroll") for (int k = 0; k < 2; ++k) dst[m][k] = *(const LAS bf16x8*)(lds + PG8_SA(b, h) + aoff + m * 2048 + k * 1024); } while (0)
#define PG8_LDB(dst, b, h) do { _Pragma("unroll") for (int n = 0; n < 2; ++n) _Pragma("unroll") for (int k = 0; k < 2; ++k) dst[n][k] = *(const LAS bf16x8*)(lds + PG8_SB(b, h) + boff + n * 2048 + k * 1024); } while (0)
#define PG8_MMA(ai, bj, At, Bt) do { __builtin_amdgcn_s_setprio(1); _Pragma("unroll") for (int m = 0; m < 4; ++m) _Pragma("unroll") for (int n = 0; n < 2; ++n) _Pragma("unroll") for (int k = 0; k < 2; ++k) \
        acc[ai][bj][m][n] = __builtin_amdgcn_mfma_f32_16x16x32_bf16(Bt[n][k], At[m][k], acc[ai][bj][m][n], 0, 0, 0); __builtin_amdgcn_s_setprio(0); } while (0)
#define PG8_WAIT_V(n) asm volatile("s_waitcnt vmcnt(" #n ")" ::: "memory")
#define PG8_WAIT_L(n) asm volatile("s_waitcnt lgkmcnt(" #n ")" ::: "memory")
#define PG8_BAR __builtin_amdgcn_s_barrier()
#define PG8_SCHED __builtin_amdgcn_sched_barrier(0)
    Unit cur, nxt; int ui = 0;
    if (!S.next(0, cur)) return;
    f32x4 acc[2][2][4][2];
#pragma unroll
    for (int a = 0; a < 2; ++a)
#pragma unroll
        for (int b = 0; b < 2; ++b)
#pragma unroll
            for (int m = 0; m < 4; ++m)
#pragma unroll
                for (int n = 0; n < 2; ++n) acc[a][b][m][n] = (f32x4){0.f, 0.f, 0.f, 0.f};
    bf16x8 At[4][2], B0[2][2], B1[2][2];
    const char* cA = (const char*)(cur.pn >= g.split ? g.A2 : g.A) + (size_t)cur.pm * tstep; const char* cB = (const char*)g.Bt + (size_t)cur.pn * tstep;
    PG8_STAGE(PG8_SB(0, 0), cB, voffB); PG8_STAGE(PG8_SA(0, 0), cA, voffA); PG8_STAGE(PG8_SB(0, 1), cB + hstep, voffB); PG8_STAGE(PG8_SA(0, 1), cA + hstep, voffA);
    if (wr == 1) PG8_BAR;
    PG8_WAIT_V(4); PG8_BAR;
    PG8_STAGE(PG8_SB(1, 0), cB + kstep, voffB); PG8_STAGE(PG8_SA(1, 0), cA + kstep, voffA); PG8_STAGE(PG8_SB(1, 1), cB + hstep + kstep, voffB);
    PG8_WAIT_V(6); PG8_BAR;
    for (;;) {
        const bool has_next = S.next(ui + 1, nxt);
        const char* nA = has_next ? (const char*)(nxt.pn >= g.split ? g.A2 : g.A) + (size_t)nxt.pm * tstep : cA; const char* nB = has_next ? (const char*)g.Bt + (size_t)nxt.pn * tstep : cB;
        for (int t = 0; t < nt; t += 2) {
            const bool last = (t == nt - 2);
            const char* a1 = cA + (size_t)(t + 1) * kstep;
            const char* a2 = last ? nA : cA + (size_t)(t + 2) * kstep; const char* b2 = last ? nB : cB + (size_t)(t + 2) * kstep;
            const char* a3 = a2 + kstep; const char* b3 = b2 + kstep;
            PG8_LDB(B0, 0, 0); PG8_SCHED; PG8_LDA(At, 0, 0); PG8_STAGE(PG8_SA(1, 1), a1 + hstep, voffA);
            PG8_WAIT_L(8); PG8_BAR; PG8_WAIT_L(0); PG8_MMA(0, 0, At, B0); PG8_BAR; PG8_SCHED;
            PG8_LDB(B1, 0, 1); PG8_STAGE(PG8_SB(0, 0), b2, voffB);
            PG8_BAR; PG8_WAIT_L(0); PG8_MMA(0, 1, At, B1); PG8_BAR;
            PG8_LDA(At, 0, 1); PG8_STAGE(PG8_SA(0, 0), a2, voffA);
            PG8_BAR; PG8_WAIT_L(0); PG8_MMA(1, 0, At, B0); PG8_BAR; PG8_SCHED;
            PG8_STAGE(PG8_SB(0, 1), b2 + hstep, voffB);
            PG8_WAIT_V(6); PG8_BAR; PG8_MMA(1, 1, At, B1); PG8_BAR;
            PG8_LDB(B0, 1, 0); PG8_SCHED; PG8_LDA(At, 1, 0); PG8_STAGE(PG8_SA(0, 1), a2 + hstep, voffA);
            PG8_WAIT_L(8); PG8_BAR; PG8_WAIT_L(0); PG8_MMA(0, 0, At, B0); PG8_BAR; PG8_SCHED;
            PG8_LDB(B1, 1, 1); PG8_STAGE(PG8_SB(1, 0), b3, voffB);
            PG8_BAR; PG8_WAIT_L(0); PG8_MMA(0, 1, At, B1); PG8_BAR;
            PG8_LDA(At, 1, 1); PG8_STAGE(PG8_SA(1, 0), a3, voffA);
            PG8_BAR; PG8_WAIT_L(0); PG8_MMA(1, 0, At, B0); PG8_BAR; PG8_SCHED;
            PG8_STAGE(PG8_SB(1, 1), b3 + hstep, voffB);
            PG8_WAIT_V(6); PG8_BAR; PG8_MMA(1, 1, At, B1); PG8_BAR;
        }
        E(acc, cur, wr, wc, fr, fq);
        if (!has_next) break;
#pragma unroll
        for (int a = 0; a < 2; ++a)
#pragma unroll
            for (int b = 0; b < 2; ++b)
#pragma unroll
                for (int m = 0; m < 4; ++m)
#pragma unroll
                    for (int n = 0; n < 2; ++n) acc[a][b][m][n] = (f32x4){0.f, 0.f, 0.f, 0.f};
        cur = nxt; cA = nA; cB = nB; ++ui;
    }
    PG8_WAIT_V(0);
    if (wr == 0) PG8_BAR;
    PG8_BAR;
#undef PG8_SA
#undef PG8_SB
#undef PG8_STAGE
#undef PG8_LDA
#undef PG8_LDB
#undef PG8_MMA
#undef PG8_WAIT_V
#undef PG8_WAIT_L
#undef PG8_BAR
#undef PG8_SCHED
}
}

__device__ __forceinline__ void p0_transpose_item(const float* W, int Nsrc, int nsrc, int k0src, bf16_t* WT, int Kdst, int ndst0, int k0dst, const float* kscale, float* scr, int lane) {
    float v[64];
    if (nsrc >= 0) {
#pragma unroll
        for (int kk = 0; kk < 64; ++kk) v[kk] = __builtin_nontemporal_load(W + (size_t)(k0src + kk) * Nsrc + nsrc);
    } else {
#pragma unroll
        for (int kk = 0; kk < 64; ++kk) v[kk] = 0.f;
    }
    if (kscale) { const float ks = kscale[k0dst + lane];
#pragma unroll
        for (int kk = 0; kk < 64; ++kk) v[kk] *= __shfl(ks, kk); }
#pragma unroll
    for (int kk = 0; kk < 64; ++kk) scr[kk * 65 + lane] = v[kk];
    asm volatile("s_waitcnt lgkmcnt(0)" ::: "memory");
    const int c = lane & 7;
#pragma unroll
    for (int j = 0; j < 8; ++j) { const int n = (lane >> 3) + 8 * j; const float* s = scr + (8 * c) * 65 + n;
        u32x4 o; o.x = cvt_pk_bf16(s[0 * 65], s[1 * 65]); o.y = cvt_pk_bf16(s[2 * 65], s[3 * 65]); o.z = cvt_pk_bf16(s[4 * 65], s[5 * 65]); o.w = cvt_pk_bf16(s[6 * 65], s[7 * 65]);
        *(u32x4*)(WT + (size_t)(ndst0 + n) * Kdst + k0dst + 8 * c) = o; }
    asm volatile("s_waitcnt lgkmcnt(0)" ::: "memory");
}

__device__ __forceinline__ void phase0(const Args& a, unsigned char* lds) {
    const int tid = ltid(), lane = tid & 63, wave = tid >> 6;
    for (int unit = blockIdx.x; unit < 96; unit += gridDim.x) {
        const int l = unit / 48, jb = unit % 48;
        float cv[3][2];
#pragma unroll
        for (int r = 0; r < 3; ++r) { const float* src = (r == 0) ? a.c_ctx : a.c + (r - 1) * 1024;
#pragma unroll
            for (int t = 0; t < 2; ++t) cv[r][t] = silu_f(src[128 * wave + 64 * t + lane]); }
        float acc0 = 0.f, acc1 = 0.f, acc2 = 0.f;
        const float* W = a.w_mod + (size_t)l * 1024 * 3072 + (size_t)(128 * wave) * 3072 + 64 * jb + lane;
#pragma unroll
        for (int t = 0; t < 2; ++t) {
#pragma unroll 32
            for (int kk = 0; kk < 64; ++kk) { const float wv = W[(size_t)(64 * t + kk) * 3072];
                acc0 += __shfl(cv[0][t], kk) * wv; acc1 += __shfl(cv[1][t], kk) * wv; acc2 += __shfl(cv[2][t], kk) * wv; }
        }
        float* red = (float*)lds;
        red[(wave * 3 + 0) * 64 + lane] = acc0; red[(wave * 3 + 1) * 64 + lane] = acc1; red[(wave * 3 + 2) * 64 + lane] = acc2;
        __syncthreads();
        if (wave < 3) { float s = 0.f;
#pragma unroll
            for (int w = 0; w < 8; ++w) s += red[(w * 3 + wave) * 64 + lane];
            ((float*)(a.ws + WS_MOD))[(l * 3 + wave) * 3072 + 64 * jb + lane] = s + a.b_mod[l * 3072 + 64 * jb + lane]; }
        __syncthreads();
    }
    float* scr = (float*)(lds + 8192 + wave * 16640);
    const int gw = blockIdx.x * 8 + wave, NGW = gridDim.x * 8;
    constexpr int I_IN = 16 * (NIN / 64), I_OUT = 2 * 16 * 16, I_L = I_IN + I_OUT;
    for (int it = gw; it < 2 * I_L; it += NGW) {
        const int l = it / I_L; int r = it % I_L;
        if (r < I_IN) {
            const int kb = r / (NIN / 64), nb = r % (NIN / 64), n0 = nb * 64;
            int ns;
            if (n0 < 2048) ns = n0 + lane;
            else if (n0 < 2560) { const int gg = (n0 - 2048) >> 8, rr = (n0 - 2048) & 255; ns = ((rr < 128) ? 2048 + 128 * gg + rr : 2304 + 128 * gg + (rr - 128)) + lane; }
            else if (n0 < 4608) { const int t = (n0 - 2560) >> 8, rr = (n0 - 2560) & 255; ns = ((rr < 128) ? 2592 + 128 * t + rr : 3616 + 128 * t + (rr - 128)) + lane; }
            else if (n0 < 5632) ns = n0 + 32 + lane;
            else if (n0 == 5632) ns = (lane < 32) ? 2560 + lane : -1;
            else ns = -1;
            p0_transpose_item(a.w_in + (size_t)l * 1024 * INCOLS, INCOLS, ns, kb * 64, (bf16_t*)(a.ws + WS_WIN + l * WIN_BYTES), 1024, n0, kb * 64, nullptr, scr, lane);
        } else {
            r -= I_IN; const int half = r / 256; r %= 256; const int kb = r / 16, nb = r % 16;
            p0_transpose_item(a.w_out + (size_t)l * 2048 * 1024, 1024, nb * 64 + lane, half * 1024 + kb * 64, (bf16_t*)(a.ws + WS_WOUT + l * WOUT_BYTES), 1024, half * 1024 + nb * 64, kb * 64,
                              half == 0 ? a.ssd_norm_g + l * 1024 : nullptr, scr, lane);
        }
    }
}

__device__ __forceinline__ void normmod_row(const f32x4 (&v)[4], const Args& a, int layer, int rg, bf16_t* hrow, int lane) {
    float s = 0.f;
#pragma unroll
    for (int j = 0; j < 4; ++j) s += (v[j][0] * v[j][0] + v[j][1] * v[j][1]) + (v[j][2] * v[j][2] + v[j][3] * v[j][3]);
    const float r = rsqrtf(wave_sum(s) * (1.f / 1024.f) + EPSF);
    const float* mod = (const float*)(a.ws + WS_MOD) + (size_t)(layer * 3 + rg) * 3072;
#pragma unroll
    for (int j = 0; j < 4; ++j) { const int c0 = 4 * lane + 256 * j;
        const f32x4 g = *(const f32x4*)(a.g_pre + layer * 1024 + c0), sh = *(const f32x4*)(mod + c0), sc = *(const f32x4*)(mod + 1024 + c0);
        f32x4 h;
#pragma unroll
        for (int e = 0; e < 4; ++e) h[e] = v[j][e] * r * g[e] * (1.f + sc[e]) + sh[e];
        u32x2 o; o.x = cvt_pk_bf16(h[0], h[1]); o.y = cvt_pk_bf16(h[2], h[3]);
        *(u32x2*)(hrow + c0) = o; }
}
__device__ __forceinline__ void normmod_row_pre(const f32x4 (&v)[4], const f32x4 (&g)[4], const f32x4 (&sh)[4], const f32x4 (&sc)[4], bf16_t* hrow, int lane) {
    float s = 0.f;
#pragma unroll
    for (int j = 0; j < 4; ++j) s += (v[j][0] * v[j][0] + v[j][1] * v[j][1]) + (v[j][2] * v[j][2] + v[j][3] * v[j][3]);
    const float r = rsqrtf(wave_sum(s) * (1.f / 1024.f) + EPSF);
#pragma unroll
    for (int j = 0; j < 4; ++j) { const int c0 = 4 * lane + 256 * j;
        f32x4 h;
#pragma unroll
        for (int e = 0; e < 4; ++e) h[e] = v[j][e] * r * g[j][e] * (1.f + sc[j][e]) + sh[j][e];
        u32x2 o; o.x = cvt_pk_bf16(h[0], h[1]); o.y = cvt_pk_bf16(h[2], h[3]);
        *(u32x2*)(hrow + c0) = o; }
}
__device__ __forceinline__ int row_group(int row) { return row < NCTXTOK ? 0 : 1 + ((row - NCTXTOK) >> 11); }

__device__ __forceinline__ void phase1(const Args& a) {
    const int lane = ltid() & 63, gw = blockIdx.x * 8 + (ltid() >> 6), NGW = gridDim.x * 8;
    for (int row0 = 2 * gw; row0 < NTOK; row0 += 2 * NGW) {
        f32x4 v[2][4];
        const float* m0 = (const float*)(a.ws + WS_MOD) + (size_t)row_group(row0) * 3072;
        f32x4 g0v[4], sh0v[4], sc0v[4];
#pragma unroll
        for (int j = 0; j < 4; ++j) { const int c0 = 4 * lane + 256 * j; g0v[j] = *(const f32x4*)(a.g_pre + c0); sh0v[j] = *(const f32x4*)(m0 + c0); sc0v[j] = *(const f32x4*)(m0 + 1024 + c0); }
#pragma unroll
        for (int t = 0; t < 2; ++t) { const int row = row0 + t;
            if (row < NTOK) { const float* xr = (row < NCTXTOK) ? a.x_prompt + (size_t)row * 1024 : a.x_sample + (size_t)(row - NCTXTOK) * 1024;
#pragma unroll
                for (int j = 0; j < 4; ++j) v[t][j] = *(const f32x4*)(xr + 4 * lane + 256 * j); } }
        float ss[2];
#pragma unroll
        for (int t = 0; t < 2; ++t) { float q = 0.f;
#pragma unroll
            for (int j = 0; j < 4; ++j) q += (v[t][j][0] * v[t][j][0] + v[t][j][1] * v[t][j][1]) + (v[t][j][2] * v[t][j][2] + v[t][j][3] * v[t][j][3]);
            ss[t] = q; }
#pragma unroll
        for (int sh = 1; sh < 64; sh <<= 1) { const float t0 = __shfl_xor(ss[0], sh), t1 = __shfl_xor(ss[1], sh); ss[0] += t0; ss[1] += t1; }
#pragma unroll
        for (int t = 0; t < 2; ++t) { const int row = row0 + t; const float r = rsqrtf(ss[t] * (1.f / 1024.f) + EPSF);
            if (row < NTOK) { bf16_t* hrow = (bf16_t*)(a.ws + WS_H) + (size_t)row * 1024;
#pragma unroll
                for (int j = 0; j < 4; ++j) { const int c0 = 4 * lane + 256 * j; f32x4 h;
#pragma unroll
                    for (int e = 0; e < 4; ++e) h[e] = v[t][j][e] * r * g0v[j][e] * (1.f + sc0v[j][e]) + sh0v[j][e];
                    u32x2 ob; ob.x = cvt_pk_bf16(h[0], h[1]); ob.y = cvt_pk_bf16(h[2], h[3]);
                    *(u32x2*)(hrow + c0) = ob; } } }
    }
}

__device__ __forceinline__ void phaseE(const Args& a, int layer) {
    const int lane = ltid() & 63, gw = blockIdx.x * 8 + (ltid() >> 6), NGW = gridDim.x * 8;
    const bf16_t* O = (const bf16_t*)(a.ws + WS_OUT);
    for (int row0 = 2 * gw; row0 < NTOK; row0 += 2 * NGW) {
        u32x2 pb[2][4], qb[2][4]; f32x4 xv[2][4]; int rows[2]; bool have[2]; float sqv[2];
        const int rgp = row_group(row0);
        const float* modp = (const float*)(a.ws + WS_MOD) + (size_t)(layer * 3 + rgp) * 3072;
        f32x4 gpv[4], gtv[4], g1v[4], sh1v[4], sc1v[4];
#pragma unroll
        for (int j = 0; j < 4; ++j) { const int c0 = 4 * lane + 256 * j; gpv[j] = *(const f32x4*)(a.g_post + layer * 1024 + c0); gtv[j] = *(const f32x4*)(modp + 2048 + c0);
            if (layer == 0) { const float* m1 = (const float*)(a.ws + WS_MOD) + (size_t)(3 + rgp) * 3072; g1v[j] = *(const f32x4*)(a.g_pre + 1024 + c0); sh1v[j] = *(const f32x4*)(m1 + c0); sc1v[j] = *(const f32x4*)(m1 + 1024 + c0); } }
#pragma unroll
        for (int t = 0; t < 2; ++t) { const int row = row0 + t; rows[t] = row; have[t] = row < NTOK; sqv[t] = 0.f;
            if (have[t]) {
                sqv[t] = ((const float*)(a.ws + WS_SSQ))[(size_t)row * 4 + (lane & 3)];
                const float* xr = (layer == 0) ? ((row < NCTXTOK) ? a.x_prompt + (size_t)row * 1024 : a.x_sample + (size_t)(row - NCTXTOK) * 1024) : a.out + (size_t)row * 1024;
#pragma unroll
                for (int j = 0; j < 4; ++j) { const int c0 = 4 * lane + 256 * j; pb[t][j] = __builtin_nontemporal_load((const u32x2*)(O + (size_t)row * 2048 + c0)); qb[t][j] = __builtin_nontemporal_load((const u32x2*)(O + (size_t)row * 2048 + 1024 + c0)); xv[t][j] = __builtin_nontemporal_load((const f32x4*)(xr + c0)); } } }
        f32x4 o[2][4]; float ssum[2], ssum2[2];
#pragma unroll
        for (int t = 0; t < 2; ++t) {
            float sq = sqv[t]; sq += __shfl_xor(sq, 1); sq += __shfl_xor(sq, 2);
            const float rsn = rsqrtf(sq * (1.f / 1024.f) + EPSF);
            float s = 0.f;
#pragma unroll
            for (int j = 0; j < 4; ++j) { const u32x2 p2 = pb[t][j], q2 = qb[t][j];
                o[t][j] = (f32x4){rsn * bf_lo(p2.x) + bf_lo(q2.x), rsn * bf_hi(p2.x) + bf_hi(q2.x), rsn * bf_lo(p2.y) + bf_lo(q2.y), rsn * bf_hi(p2.y) + bf_hi(q2.y)};
                s += (o[t][j][0] * o[t][j][0] + o[t][j][1] * o[t][j][1]) + (o[t][j][2] * o[t][j][2] + o[t][j][3] * o[t][j][3]); }
            ssum[t] = s; }
#pragma unroll
        for (int sh = 1; sh < 64; sh <<= 1) { const float t0 = __shfl_xor(ssum[0], sh), t1 = __shfl_xor(ssum[1], sh); ssum[0] += t0; ssum[1] += t1; }
#pragma unroll
        for (int t = 0; t < 2; ++t) { const float r = rsqrtf(ssum[t] * (1.f / 1024.f) + EPSF); float s2 = 0.f;
#pragma unroll
            for (int j = 0; j < 4; ++j) { const f32x4 gp = gpv[j], gt = gtv[j];
#pragma unroll
                for (int e = 0; e < 4; ++e) xv[t][j][e] = xv[t][j][e] + gt[e] * (o[t][j][e] * r * gp[e]);
                s2 += (xv[t][j][0] * xv[t][j][0] + xv[t][j][1] * xv[t][j][1]) + (xv[t][j][2] * xv[t][j][2] + xv[t][j][3] * xv[t][j][3]);
                if (have[t]) __builtin_nontemporal_store(xv[t][j], (f32x4*)(a.out + (size_t)rows[t] * 1024 + 4 * lane + 256 * j)); }
            ssum2[t] = s2; }
        if (layer == 0) {
#pragma unroll
            for (int sh = 1; sh < 64; sh <<= 1) { const float t0 = __shfl_xor(ssum2[0], sh), t1 = __shfl_xor(ssum2[1], sh); ssum2[0] += t0; ssum2[1] += t1; }
#pragma unroll
            for (int t = 0; t < 2; ++t) if (have[t]) { const float r1 = rsqrtf(ssum2[t] * (1.f / 1024.f) + EPSF); bf16_t* hrow = (bf16_t*)(a.ws + WS_H) + (size_t)rows[t] * 1024;
#pragma unroll
                for (int j = 0; j < 4; ++j) { const int c0 = 4 * lane + 256 * j; f32x4 h;
#pragma unroll
                    for (int e = 0; e < 4; ++e) h[e] = xv[t][j][e] * r1 * g1v[j][e] * (1.f + sc1v[j][e]) + sh1v[j][e];
                    u32x2 ob; ob.x = cvt_pk_bf16(h[0], h[1]); ob.y = cvt_pk_bf16(h[2], h[3]);
                    *(u32x2*)(hrow + c0) = ob; } }
        }
    }
}

__device__ __forceinline__ int vblock() { const int G = gridDim.x, bx = blockIdx.x; return (G % 8 == 0) ? (bx % 8) * (G / 8) + bx / 8 : bx; }
constexpr int XT_OFF = 0, XT_PITCH = 272, CN_OFF = 69632, BN_OFF = 104448, QA_OFF = 139264, DTA_OFF = 143360, SCA_OFF = 147456;
constexpr int YL_PITCH = 260;

struct SsdUnit { int cu, g, hh, row0, tl0, L; bool ctx; int c; };
__device__ __forceinline__ SsdUnit ssd_unit(int u) {
    SsdUnit s; s.cu = u >> 2; s.g = (u >> 1) & 1; s.hh = u & 1;
    if (s.cu < 32) { s.ctx = true; const int b = s.cu >> 1; s.c = s.cu & 1; s.L = 256; s.row0 = b * 256 + s.c * 128; }
    else { s.ctx = false; const int v = s.cu - 32, b = v >> 4; s.c = v & 15; s.L = 2048; s.row0 = NCTXTOK + b * 2048 + s.c * 128; }
    s.tl0 = s.c * 128; return s;
}

__device__ __forceinline__ f32x2 silu2(f32x2 v) {
    const f32x2 t = v * (-1.44269504f);
    f32x2 e; e[0] = __builtin_amdgcn_exp2f(t[0]); e[1] = __builtin_amdgcn_exp2f(t[1]);
    const f32x2 d = e + 1.0f;
    f32x2 r; r[0] = __builtin_amdgcn_rcpf(d[0]); r[1] = __builtin_amdgcn_rcpf(d[1]);
    return v * r;
}
template <bool BTR, bool NEEDC>
__device__ __forceinline__ void ssd_load_conv(unsigned char* lds, const bf16_t* U, const float* cw, const float* cbias, const SsdUnit& su) {
    const int tid = ltid(), lane = tid & 63, wave = tid >> 6, seg = wave >> 1;
    const int cgi = (wave & 1) * 64 + lane;
    int kind, ucol, cg4;
    if (cgi < 64) { kind = 0; cg4 = cgi; ucol = U_X + (su.g * 8 + su.hh * 4) * 64 + cg4 * 4; }
    else if (cgi < 96) { kind = 1; cg4 = cgi - 64; ucol = U_B + su.g * 256 + cg4 * 4; }
    else { kind = 2; cg4 = cgi - 96; ucol = U_C + su.g * 256 + cg4 * 4; }
    if (!NEEDC && kind == 2) return;
    const int ch = (kind == 0) ? ucol - 1024 : (kind == 1 ? 1024 + su.g * 128 + cg4 * 4 : 1280 + su.g * 128 + cg4 * 4);
    f32x2 w[5][2], bia[2];
#pragma unroll
    for (int k = 0; k < 5; ++k) { const f32x4 w0 = *(const f32x4*)(cw + k * 1536 + ch); w[k][0] = (f32x2){w0[0], w0[1]}; w[k][1] = (f32x2){w0[2], w0[3]}; }
    { const f32x4 b0 = *(const f32x4*)(cbias + ch); bia[0] = (f32x2){b0[0], b0[1]}; bia[1] = (f32x2){b0[2], b0[3]}; }
    const bool transposed = (kind == 0) || (BTR && kind == 1);
    const int seq_row0 = su.row0 - su.tl0;
    u32x2 rawall[36];
#pragma unroll
    for (int i = 0; i < 36; ++i) { int tl = su.tl0 + seg * 32 - 2 + i;
        if (i < 2) tl = tl < 0 ? 0 : tl;
        if (i >= 34) tl = tl >= su.L ? su.L - 1 : tl;
        rawall[i] = *(const u32x2*)((const char*)U + uoff((unsigned)(seq_row0 + tl), (unsigned)ucol)); }
    { const unsigned mlo = (su.tl0 + seg * 32 - 2 < 0) ? 0u : 0xffffffffu, mhi = (su.tl0 + seg * 32 + 34 > su.L) ? 0u : 0xffffffffu;
      rawall[0].x &= mlo; rawall[0].y &= mlo; rawall[1].x &= mlo; rawall[1].y &= mlo;
      rawall[34].x &= mhi; rawall[34].y &= mhi; rawall[35].x &= mhi; rawall[35].y &= mhi; }
#pragma unroll
    for (int sub = 0; sub < 4; ++sub) {
        const int rr = seg * 32 + sub * 8;
        f32x2 o[8][2];
#pragma unroll
        for (int r = 0; r < 8; ++r) { o[r][0] = bia[0]; o[r][1] = bia[1]; }
#pragma unroll
        for (int i = 0; i < 12; ++i) { const u32x2 rw = rawall[sub * 8 + i];
            const f32x2 v0 = (f32x2){bf_lo(rw.x), bf_hi(rw.x)}, v1 = (f32x2){bf_lo(rw.y), bf_hi(rw.y)};
#pragma unroll
            for (int k = 0; k < 5; ++k) { const int r = i - k; if (r >= 0 && r < 8) { o[r][0] = __builtin_elementwise_fma(w[k][0], v0, o[r][0]); o[r][1] = __builtin_elementwise_fma(w[k][1], v1, o[r][1]); } } }
#pragma unroll
        for (int r = 0; r < 8; ++r) { o[r][0] = silu2(o[r][0]); o[r][1] = silu2(o[r][1]); }
        if (transposed) {
            unsigned char* base = lds + (kind == 0 ? XT_OFF : CN_OFF);
            const int chunk = rr >> 3;
#pragma unroll
            for (int e = 0; e < 4; ++e) { const int R = cg4 * 4 + e; const int phys = chunk ^ ((R >> 3) & 3);
                u32x4 pk; pk.x = cvt_pk_bf16(o[0][e >> 1][e & 1], o[1][e >> 1][e & 1]); pk.y = cvt_pk_bf16(o[2][e >> 1][e & 1], o[3][e >> 1][e & 1]);
                pk.z = cvt_pk_bf16(o[4][e >> 1][e & 1], o[5][e >> 1][e & 1]); pk.w = cvt_pk_bf16(o[6][e >> 1][e & 1], o[7][e >> 1][e & 1]);
                *(u32x4*)(base + R * XT_PITCH + phys * 16) = pk; }
        } else {
            unsigned char* base = lds + (kind == 1 ? BN_OFF : CN_OFF);
#pragma unroll
            for (int r = 0; r < 8; ++r) { u32x2 pk; pk.x = cvt_pk_bf16(o[r][0][0], o[r][0][1]); pk.y = cvt_pk_bf16(o[r][1][0], o[r][1][1]);
                *(u32x2*)(base + (rr + r) * XT_PITCH + cg4 * 8) = pk; }
        }
    }
}

__device__ __forceinline__ float ssd_dtq(unsigned char* lds, int slot, const float* DT, int row0, int head, int d, const float* a_log_l, const float* dt_bias_l, bool want_sc) {
    const int lane = ltid() & 63;
    const float bias = dt_bias_l[d * 16 + head], av = -__expf(a_log_l[d * 16 + head]);
    const float r0 = DT[(size_t)(row0 + 2 * lane) * 32 + d * 16 + head], r1 = DT[(size_t)(row0 + 2 * lane + 1) * 32 + d * 16 + head];
    const float dt0 = softplus_f(r0 + bias), dt1 = softplus_f(r1 + bias);
    const float la0 = dt0 * av, la1 = dt1 * av, s = la0 + la1;
    float incl = s;
#pragma unroll
    for (int o = 1; o < 64; o <<= 1) { const float t = __shfl_up(incl, o); if (lane >= o) incl += t; }
    const float tot = __shfl(incl, 63), excl = incl - s;
    float q0, q1;
    if (d == 0) { q0 = excl + la0; q1 = incl; } else { q0 = tot - excl; q1 = tot - excl - la0; }
    float* QA = (float*)(lds + QA_OFF) + slot * 128; float* DTA = (float*)(lds + DTA_OFF) + slot * 128;
    *(f32x2*)(QA + 2 * lane) = (f32x2){q0 * 1.44269504f, q1 * 1.44269504f}; *(f32x2*)(DTA + 2 * lane) = (f32x2){q0 * 1.44269504f - __log2f(dt0), q1 * 1.44269504f - __log2f(dt1)};
    if (want_sc) { float* SCA = (float*)(lds + SCA_OFF) + slot * 128; *(f32x2*)(SCA + 2 * lane) = (f32x2){dt0 * __expf(tot - q0), dt1 * __expf(tot - q1)}; }
    return tot;
}

__device__ __forceinline__ bf16x8 as_bf16x8(u32x4 v) { return __builtin_bit_cast(bf16x8, v); }

__device__ __forceinline__ void phaseB1(const Args& a, unsigned char* lds, int layer) {
    const int tid = ltid(), lane = tid & 63, wave = tid >> 6, fr = lane & 15, fq = lane >> 4;
    const bf16_t* U = (const bf16_t*)(a.ws + WS_U); const float* DT = (const float*)(a.ws + WS_DT);
    float* ST = (float*)(a.ws + WS_ST); float* TOT = (float*)(a.ws + WS_TOT);
    for (int u = vblock(); u < 256; u += gridDim.x) {
        const SsdUnit su = ssd_unit(u);
        const int i = wave >> 1, d = wave & 1, head = su.g * 8 + su.hh * 4 + i;
        const float tot = ssd_dtq(lds, wave, DT, su.row0, head, d, a.a_log + layer * 32, a.dt_bias + layer * 32, true);
        const size_t sidx = (size_t)((su.cu * 16 + head) * 2 + d);
        if (lane == 0) TOT[sidx] = tot;
        ssd_load_conv<true, false>(lds, U, a.ssd_conv_w + (size_t)layer * 5 * 1536, a.ssd_conv_b + layer * 1536, su);
        __syncthreads();
        const float* SCA = (const float*)(lds + SCA_OFF) + wave * 128;
        bf16x8 Af[4][4];
#pragma unroll
        for (int pt = 0; pt < 4; ++pt)
#pragma unroll
            for (int ks = 0; ks < 4; ++ks) { const int R = i * 64 + pt * 16 + fr, chunk = ks * 4 + fq;
                const u32x4 xr = *(const u32x4*)(lds + XT_OFF + R * XT_PITCH + ((chunk ^ ((R >> 3) & 3)) * 16));
                const f32x4 s0 = *(const f32x4*)(SCA + chunk * 8), s1 = *(const f32x4*)(SCA + chunk * 8 + 4);
                u32x4 o; o.x = cvt_pk_bf16(bf_lo(xr.x) * s0[0], bf_hi(xr.x) * s0[1]); o.y = cvt_pk_bf16(bf_lo(xr.y) * s0[2], bf_hi(xr.y) * s0[3]);
                o.z = cvt_pk_bf16(bf_lo(xr.z) * s1[0], bf_hi(xr.z) * s1[1]); o.w = cvt_pk_bf16(bf_lo(xr.w) * s1[2], bf_hi(xr.w) * s1[3]);
                Af[pt][ks] = as_bf16x8(o); }
        float* stp = ST + sidx * 8192;
#pragma unroll 1
        for (int nt = 0; nt < 8; ++nt) {
            f32x4 acc[4];
#pragma unroll
            for (int pt = 0; pt < 4; ++pt) acc[pt] = (f32x4){0.f, 0.f, 0.f, 0.f};
#pragma unroll
            for (int ks = 0; ks < 4; ++ks) { const int n = nt * 16 + fr, chunk = ks * 4 + fq;
                const bf16x8 Bf = *(const bf16x8*)(lds + CN_OFF + n * XT_PITCH + ((chunk ^ ((n >> 3) & 3)) * 16));
#pragma unroll
                for (int pt = 0; pt < 4; ++pt) acc[pt] = __builtin_amdgcn_mfma_f32_16x16x32_bf16(Bf, Af[pt][ks], acc[pt], 0, 0, 0); }
#pragma unroll
            for (int pt = 0; pt < 4; ++pt) {
                if (su.ctx) *(f32x4*)(stp + (pt * 16 + fr) * 128 + nt * 16 + 4 * fq) = acc[pt];
                else { u32x2 o; o.x = cvt_pk_bf16(acc[pt][0], acc[pt][1]); o.y = cvt_pk_bf16(acc[pt][2], acc[pt][3]); *(u32x2*)((bf16_t*)stp + (pt * 16 + fr) * 128 + nt * 16 + 4 * fq) = o; } }
        }
        __syncthreads();
    }
}

__device__ __forceinline__ void phaseScan(const Args& a, int layer) {
    const float* ST = (const float*)(a.ws + WS_ST); const float* TOT = (const float*)(a.ws + WS_TOT);
    bf16_t* SINL = (bf16_t*)(a.ws + WS_SINL); bf16_t* SINC = (bf16_t*)(a.ws + WS_SINC);
    const int gid = blockIdx.x * 512 + ltid(), GT = gridDim.x * 512;
    for (int id = gid; id < 64 * 2048; id += GT) {
        const int chain = id >> 11, e4 = id & 2047, b = chain >> 5, h = (chain >> 1) & 15, d = chain & 1;
        f32x4 S = *(const f32x4*)(a.state_ssd + ((size_t)(((b * 2 + layer) * 2 + d) * 16 + h)) * 8192 + e4 * 4);
        f32x4 t[16]; float dec[16];
#pragma unroll
        for (int s = 0; s < 16; ++s) { const int c = d ? 15 - s : s; const size_t sidx = (size_t)(((32 + b * 16 + c) * 16 + h) * 2 + d);
            const u32x2 tb = *(const u32x2*)((const bf16_t*)(ST + sidx * 8192) + e4 * 4); t[s] = (f32x4){bf_lo(tb.x), bf_hi(tb.x), bf_lo(tb.y), bf_hi(tb.y)}; dec[s] = __expf(TOT[sidx]); }
#pragma unroll
        for (int s = 0; s < 16; ++s) { const int c = d ? 15 - s : s; const size_t lidx = (size_t)(((b * 16 + c) * 16 + h) * 2 + d);
            u32x2 o; o.x = cvt_pk_bf16(S[0], S[1]); o.y = cvt_pk_bf16(S[2], S[3]);
            *(u32x2*)(SINL + lidx * 8192 + e4 * 4) = o; S = S * dec[s] + t[s]; }
    }
    float* ns = a.out + (size_t)NTOK * 1024;
    for (int id = gid; id < 512 * 2048; id += GT) {
        const int chain = id >> 11, e4 = id & 2047, b = chain >> 5, h = (chain >> 1) & 15, d = chain & 1;
        const int c1 = d ? 1 : 0, c2 = d ? 0 : 1;
        const size_t s1 = (size_t)(((b * 2 + c1) * 16 + h) * 2 + d), s2 = (size_t)(((b * 2 + c2) * 16 + h) * 2 + d);
        const f32x4 v1 = *(const f32x4*)(ST + s1 * 8192 + e4 * 4), v2 = *(const f32x4*)(ST + s2 * 8192 + e4 * 4);
        u32x2 o; o.x = cvt_pk_bf16(v1[0], v1[1]); o.y = cvt_pk_bf16(v1[2], v1[3]);
        *(u32x2*)(SINC + (size_t)chain * 8192 + e4 * 4) = o;
        *(f32x4*)(ns + ((size_t)(((b * 2 + layer) * 2 + d) * 16 + h)) * 8192 + e4 * 4) = v1 * __expf(TOT[s2]) + v2;
    }
}

__device__ __forceinline__ void phaseB3(const Args& a, unsigned char* lds, int layer) {
    const int tid = ltid(), lane = tid & 63, wave = tid >> 6, fr = lane & 15, fq = lane >> 4;
    const bf16_t* U = (const bf16_t*)(a.ws + WS_U); const float* DT = (const float*)(a.ws + WS_DT);
    const bf16_t* SINL = (const bf16_t*)(a.ws + WS_SINL); const bf16_t* SINC = (const bf16_t*)(a.ws + WS_SINC); float* SSQ = (float*)(a.ws + WS_SSQ); bf16_t* YS = (bf16_t*)(a.ws + WS_YS);
    for (int u = vblock(); u < 256; u += gridDim.x) {
        const SsdUnit su = ssd_unit(u);
        { const int i = wave >> 1, d = wave & 1, head = su.g * 8 + su.hh * 4 + i;
          (void)ssd_dtq(lds, wave, DT, su.row0, head, d, a.a_log + layer * 32, a.dt_bias + layer * 32, false); }
        ssd_load_conv<false, true>(lds, U, a.ssd_conv_w + (size_t)layer * 5 * 1536, a.ssd_conv_b + layer * 1536, su);
        __syncthreads();
        {
            bf16x8 Af[4];
#pragma unroll
            for (int ks = 0; ks < 4; ++ks) Af[ks] = *(const bf16x8*)(lds + BN_OFF + (16 * wave + fr) * XT_PITCH + (ks * 4 + fq) * 16);
            f32x4 cacc[8];
#pragma unroll
            for (int lt = 0; lt < 8; ++lt) { cacc[lt] = (f32x4){0.f, 0.f, 0.f, 0.f};
#pragma unroll
                for (int ks = 0; ks < 4; ++ks) { const bf16x8 Bf = *(const bf16x8*)(lds + CN_OFF + (lt * 16 + fr) * XT_PITCH + (ks * 4 + fq) * 16);
                    cacc[lt] = __builtin_amdgcn_mfma_f32_16x16x32_bf16(Af[ks], Bf, cacc[lt], 0, 0, 0); } }
            __syncthreads();
#pragma unroll
            for (int lt = 0; lt < 8; ++lt) { u32x2 o; o.x = cvt_pk_bf16(cacc[lt][0], cacc[lt][1]); o.y = cvt_pk_bf16(cacc[lt][2], cacc[lt][3]);
                *(u32x2*)(lds + BN_OFF + (lt * 16 + fr) * XT_PITCH + (16 * wave + 4 * fq) * 2) = o; }
            __syncthreads();
        }
        const int i = wave >> 1, lh = wave & 1, head = su.g * 8 + su.hh * 4 + i;
        f32x4 y[4][4];
#pragma unroll
        for (int pt = 0; pt < 4; ++pt)
#pragma unroll
            for (int lt = 0; lt < 4; ++lt) y[pt][lt] = (f32x4){0.f, 0.f, 0.f, 0.f};
#pragma unroll 1
        for (int d = 0; d < 2; ++d) {
            int frd = fr, fqd = fq; asm volatile("" : "+v"(frd), "+v"(fqd));

            const float* QA = (const float*)(lds + QA_OFF) + (i * 2 + d) * 128; const float* DTA = (const float*)(lds + DTA_OFF) + (i * 2 + d) * 128;
            const bf16_t* Sp = nullptr;
            if (su.ctx) { const int b = su.cu >> 1; if ((d == 0 && su.c == 1) || (d == 1 && su.c == 0)) Sp = SINC + (size_t)((b * 16 + head) * 2 + d) * 8192; }
            else Sp = SINL + (size_t)(((su.cu - 32) * 16 + head) * 2 + d) * 8192;
            u32x4 Sf[4][4];
            if (Sp) {
#pragma unroll
                for (int pt = 0; pt < 4; ++pt)
#pragma unroll
                    for (int ks = 0; ks < 2; ++ks) Sf[pt][ks] = *(const u32x4*)((const char*)Sp + (unsigned)(((pt * 16 + frd) * 128 + ks * 32 + fqd * 8) * 2));
            }
#pragma unroll
            for (int lt = 0; lt < 4; ++lt) { const int l0 = 64 * lh + lt * 16, l = l0 + frd; const float ql = QA[l];
#pragma unroll
                for (int ks = 0; ks < 4; ++ks) {
                    const bool skip = (d == 0) ? (32 * ks > l0 + 15) : (32 * ks + 31 < l0);
                    if (!skip) {
                        const int s0i = ks * 32 + fqd * 8;
                        const u32x4 cr = *(const u32x4*)(lds + BN_OFF + l * XT_PITCH + s0i * 2);
                        const f32x4 da = *(const f32x4*)(DTA + s0i), db = *(const f32x4*)(DTA + s0i + 4);
                        float cv[8] = {bf_lo(cr.x), bf_hi(cr.x), bf_lo(cr.y), bf_hi(cr.y), bf_lo(cr.z), bf_hi(cr.z), bf_lo(cr.w), bf_hi(cr.w)};
                        float gsv[8] = {da[0], da[1], da[2], da[3], db[0], db[1], db[2], db[3]};
                        float pv[8];
#pragma unroll
                        for (int j = 0; j < 8; ++j) { const int s = s0i + j; const bool ok = (d == 0) ? (s <= l) : (s >= l);
                            pv[j] = ok ? cv[j] * __builtin_amdgcn_exp2f(ql - gsv[j]) : 0.f; }
                        u32x4 o; o.x = cvt_pk_bf16(pv[0], pv[1]); o.y = cvt_pk_bf16(pv[2], pv[3]); o.z = cvt_pk_bf16(pv[4], pv[5]); o.w = cvt_pk_bf16(pv[6], pv[7]);
                        const bf16x8 Pf = as_bf16x8(o);
#pragma unroll
                        for (int pt = 0; pt < 4; ++pt) { const int R = i * 64 + pt * 16 + frd, chunk = ks * 4 + fqd;
                            const bf16x8 Af = *(const bf16x8*)(lds + XT_OFF + R * XT_PITCH + ((chunk ^ ((R >> 3) & 3)) * 16));
                            y[pt][lt] = __builtin_amdgcn_mfma_f32_16x16x32_bf16(Af, Pf, y[pt][lt], 0, 0, 0); }
                    }
                } }
            if (Sp) {
#pragma unroll
                for (int pt = 0; pt < 4; ++pt)
#pragma unroll
                    for (int ks = 2; ks < 4; ++ks) Sf[pt][ks] = *(const u32x4*)((const char*)Sp + (unsigned)(((pt * 16 + frd) * 128 + ks * 32 + fqd * 8) * 2));
                float eq[4];
#pragma unroll
                for (int lt = 0; lt < 4; ++lt) eq[lt] = __builtin_amdgcn_exp2f(QA[64 * lh + lt * 16 + frd]);
#pragma unroll
                for (int ks = 0; ks < 4; ++ks) {
                    bf16x8 Bf[4];
#pragma unroll
                    for (int lt = 0; lt < 4; ++lt) { const int l = 64 * lh + lt * 16 + frd; const float e1 = eq[lt];
                        const u32x4 cr = *(const u32x4*)(lds + CN_OFF + l * XT_PITCH + (ks * 4 + fqd) * 16);
                        u32x4 o; o.x = cvt_pk_bf16(bf_lo(cr.x) * e1, bf_hi(cr.x) * e1); o.y = cvt_pk_bf16(bf_lo(cr.y) * e1, bf_hi(cr.y) * e1);
                        o.z = cvt_pk_bf16(bf_lo(cr.z) * e1, bf_hi(cr.z) * e1); o.w = cvt_pk_bf16(bf_lo(cr.w) * e1, bf_hi(cr.w) * e1);
                        Bf[lt] = as_bf16x8(o); }
#pragma unroll
                    for (int pt = 0; pt < 4; ++pt)
#pragma unroll
                        for (int lt = 0; lt < 4; ++lt) y[pt][lt] = __builtin_amdgcn_mfma_f32_16x16x32_bf16(as_bf16x8(Sf[pt][ks]), Bf[lt], y[pt][lt], 0, 0, 0);
                }
            }
        }
        { const float Dh = a.ssd_d[layer * 16 + head];
#pragma unroll
          for (int pt = 0; pt < 4; ++pt)
#pragma unroll
            for (int lt = 0; lt < 4; ++lt) { const int l = 64 * lh + lt * 16 + fr;
#pragma unroll
                for (int r = 0; r < 4; ++r) { const int R = i * 64 + pt * 16 + 4 * fq + r;
                    const unsigned short xv = *(const unsigned short*)(lds + XT_OFF + R * XT_PITCH + (((l >> 3) ^ ((R >> 3) & 3)) * 16) + (l & 7) * 2);
                    y[pt][lt][r] += Dh * __uint_as_float((unsigned)xv << 16); } } }
        const int cgz = tid & 31, rsub = tid >> 5; const int zc = (su.g * 8 + su.hh * 4) * 64 + cgz * 8;
        u32x4 zr[8];
#pragma unroll
        for (int ps = 0; ps < 8; ++ps) zr[ps] = *(const u32x4*)((const char*)U + uoff((unsigned)(su.row0 + ps * 16 + rsub), (unsigned)(U_Z + zc)));
        __syncthreads();
        { float* YL = (float*)lds;
#pragma unroll
          for (int pt = 0; pt < 4; ++pt)
#pragma unroll
            for (int lt = 0; lt < 4; ++lt) { const int l = 64 * lh + lt * 16 + fr; *(f32x4*)(YL + l * YL_PITCH + i * 64 + pt * 16 + 4 * fq) = y[pt][lt]; } }
        __syncthreads();
        { const float* YL = (const float*)lds;
#pragma unroll
          for (int ps = 0; ps < 8; ++ps) { const int l = ps * 16 + rsub; const unsigned row = (unsigned)(su.row0 + l);
              const f32x4 y0 = *(const f32x4*)(YL + l * YL_PITCH + cgz * 8), y1 = *(const f32x4*)(YL + l * YL_PITCH + cgz * 8 + 4);
              const u32x4 z4 = zr[ps];
              float v[8] = {y0[0] * bf_lo(z4.x), y0[1] * bf_hi(z4.x), y0[2] * bf_lo(z4.y), y0[3] * bf_hi(z4.y),
                            y1[0] * bf_lo(z4.z), y1[1] * bf_hi(z4.z), y1[2] * bf_lo(z4.w), y1[3] * bf_hi(z4.w)};
              float ss = 0.f;
#pragma unroll
              for (int j = 0; j < 8; ++j) ss += v[j] * v[j];
              u32x4 o; o.x = cvt_pk_bf16(v[0], v[1]); o.y = cvt_pk_bf16(v[2], v[3]); o.z = cvt_pk_bf16(v[4], v[5]); o.w = cvt_pk_bf16(v[6], v[7]);
              *(u32x4*)((char*)YS + (row * 2048u + (unsigned)(zc * 2))) = o;
#pragma unroll
              for (int m = 1; m < 32; m <<= 1) ss += __shfl_xor(ss, m);
              if (cgz == 0) SSQ[(size_t)row * 4 + su.g * 2 + su.hh] = ss; } }
        __syncthreads();
    }
}

__device__ __forceinline__ void phaseConf(const Args& a, unsigned char* lds, int layer) {
    const int tid = ltid();
    const bf16_t* U = (const bf16_t*)(a.ws + WS_U); bf16_t* YC = (bf16_t*)(a.ws + WS_YC);
    const int c0 = 2 * tid; const unsigned voff = (unsigned)(c0 * 2);
    f32x2 w[31];
#pragma unroll
    for (int k = 0; k < 31; ++k) w[k] = *(const f32x2*)((const char*)a.conf_conv_w + ((unsigned)((layer * 31 + k) * 4096) + 2u * voff));
    const f32x2 cb2 = *(const f32x2*)((const char*)a.conf_conv_b + ((unsigned)(layer * 4096) + 2u * voff));
    const f32x2 lg = *(const f32x2*)((const char*)a.conf_ln_g + ((unsigned)(layer * 4096) + 2u * voff)), lb = *(const f32x2*)((const char*)a.conf_ln_b + ((unsigned)(layer * 4096) + 2u * voff));
#pragma unroll 1
    for (int u = vblock(); u < 512; u += gridDim.x) {
        int rbase, rstride, pos0, plen;
        if (u < 256) { const int b = u >> 4; pos0 = (u & 15) * 16; plen = 256; rbase = b * 256; rstride = 1; }
        else { const int v = u - 256, b = v >> 7, wc = (v >> 1) & 63; pos0 = (v & 1) * 16; plen = 32; rbase = NCTXTOK + b * 2048 + wc; rstride = 64; }
        unsigned ra[46], gs[16];
#pragma unroll
        for (int i = 0; i < 46; ++i) { ra[i] = 0u; const int pos = pos0 + i - 15;
            if (pos >= 0 && pos < plen) ra[i] = *(const unsigned*)((const char*)U + uoff((unsigned)(rbase + pos * rstride), (unsigned)(U_GA + c0))); }
#pragma unroll
        for (int o = 0; o < 16; ++o) gs[o] = *(const unsigned*)((const char*)U + uoff((unsigned)(rbase + (pos0 + o) * rstride), (unsigned)(U_GS + c0)));
        f32x2 acc[16];
#pragma unroll
        for (int o = 0; o < 16; ++o) acc[o] = cb2;
#pragma unroll
        for (int i = 0; i < 46; ++i) { const f32x2 hh = (f32x2){bf_lo(ra[i]), bf_hi(ra[i])};
#pragma unroll
            for (int o = 0; o < 16; ++o) { const int k = i - o; if (k >= 0 && k < 31) acc[o] = __builtin_elementwise_fma(w[k], hh, acc[o]); } }
        float* red = (float*)lds;
#pragma unroll
        for (int o = 0; o < 16; ++o) { red[o * 512 + tid] = acc[o][0] + acc[o][1]; red[8192 + o * 512 + tid] = acc[o][0] * acc[o][0] + acc[o][1] * acc[o][1]; }
        __syncthreads();
        { const int o = tid >> 5, part = tid & 31; float s = 0.f, q = 0.f;
#pragma unroll
          for (int j = 0; j < 4; ++j) { const f32x4 t = *(const f32x4*)(red + o * 512 + part * 16 + j * 4), t2 = *(const f32x4*)(red + 8192 + o * 512 + part * 16 + j * 4);
              s += (t[0] + t[1]) + (t[2] + t[3]); q += (t2[0] + t2[1]) + (t2[2] + t2[3]); }
#pragma unroll
          for (int m = 1; m < 32; m <<= 1) { s += __shfl_xor(s, m); q += __shfl_xor(q, m); }
          __syncthreads();
          if (part == 0) { const float mean = s * (1.f / 1024.f); const float var = fmaxf(q * (1.f / 1024.f) - mean * mean, 0.f); red[2 * o] = mean; red[2 * o + 1] = rsqrtf(var + EPSF); } }
        __syncthreads();
#pragma unroll
        for (int o = 0; o < 16; ++o) { const unsigned row = (unsigned)(rbase + (pos0 + o) * rstride); const float mean = red[2 * o], rstd = red[2 * o + 1];
            const float v0 = silu_f((acc[o][0] - mean) * rstd * lg[0] + lb[0]) * bf_lo(gs[o]), v1 = silu_f((acc[o][1] - mean) * rstd * lg[1] + lb[1]) * bf_hi(gs[o]);
            *(unsigned*)((char*)YC + (row * 2048u + voff)) = cvt_pk_bf16(v0, v1); }
        __syncthreads();
    }
}

#define XB_TMO      128
#define XB_XCNT(j)  (256  + 64 * (j))
#define XB_XSUB(j)  (1280 + 64 * (j))
#define XB_XGEN(j)  (2304 + 64 * (j))
#define XB_TOP      3328
#define XB_TOPGEN   3392
#define XCD_BAR_WORDS 3456
#define XB_SPIN_CAP (1u << 18)
__device__ __forceinline__ unsigned xb_ld(unsigned* p)              { return __hip_atomic_load(p, __ATOMIC_RELAXED, __HIP_MEMORY_SCOPE_AGENT); }
__device__ __forceinline__ unsigned xb_add(unsigned* p, unsigned v) { return __hip_atomic_fetch_add(p, v, __ATOMIC_RELAXED, __HIP_MEMORY_SCOPE_AGENT); }
__device__ __forceinline__ unsigned xb_xcc_id() { return (unsigned)__builtin_amdgcn_s_getreg((3 << 11) | 20) & 0xFu; }
#define XB_SPIN(cond, bar) do { unsigned _sp = 0; while (cond) { __builtin_amdgcn_s_sleep(1); \
    if ((++_sp & 255u) == 0u) { if (xb_ld(&(bar)[XB_TMO])) break; if (_sp > XB_SPIN_CAP) { atomicAdd(&(bar)[XB_TMO], 1u); break; } } } } while (0)
struct XcdBarrier { unsigned* bar; unsigned x; volatile LAS unsigned* st; };
__device__ __forceinline__ XcdBarrier xcd_barrier_post(unsigned* bar, volatile LAS unsigned* st) {
    XcdBarrier b; b.bar = bar; b.x = xb_xcc_id(); b.st = st;
    if (threadIdx.x == 0) (void)xb_add(&bar[XB_XCNT(b.x)], 1u);
    return b;
}
__device__ __forceinline__ void xcd_barrier_complete(unsigned* bar, unsigned x, unsigned& nloc, unsigned& nx) {
    const unsigned G = gridDim.x * gridDim.y * gridDim.z;
    unsigned sum, cnt, mine, sp = 0u;
    for (;;) {
        sum = 0u; cnt = 0u; mine = 0u;
#pragma unroll
        for (unsigned j = 0; j < 16; ++j) { const unsigned c = xb_ld(&bar[XB_XCNT(j)]); sum += c; cnt += (c > 0u) ? 1u : 0u; mine = (j == x) ? c : mine; }
        if (sum == G) break;
        __builtin_amdgcn_s_sleep(1);
        if ((++sp & 255u) == 0u) { if (xb_ld(&bar[XB_TMO])) break; if (sp > XB_SPIN_CAP) { atomicAdd(&bar[XB_TMO], 1u); break; } }
    }
    nloc = mine > 0u ? mine : 1u; nx = cnt > 0u ? cnt : 1u;
}
__device__ __forceinline__ void xcd_barrier(const XcdBarrier& b) {
    asm volatile("s_waitcnt vmcnt(0)" ::: "memory");
    __syncthreads();
    if (threadIdx.x == 0) {
        unsigned* bar = b.bar;
        __builtin_amdgcn_s_waitcnt(0);
        unsigned nloc = b.st[0], nx = b.st[1];
        if (nloc == 0u) { xcd_barrier_complete(bar, b.x, nloc, nx); b.st[0] = nloc; b.st[1] = nx; }
        const unsigned old = xb_add(&bar[XB_XSUB(b.x)], 1u);
        const unsigned gen = old / nloc;
        if (old + 1u == (gen + 1u) * nloc) {
            __builtin_amdgcn_fence(__ATOMIC_RELEASE, "agent");
            asm volatile("s_waitcnt vmcnt(0)" ::: "memory");
            const unsigned og = xb_add(&bar[XB_TOP], 1u);
            const unsigned tg = og / nx;
            if (og + 1u == (tg + 1u) * nx) xb_add(&bar[XB_TOPGEN], 1u);
            else XB_SPIN(xb_ld(&bar[XB_TOPGEN]) == tg, bar);
            __builtin_amdgcn_fence(__ATOMIC_ACQUIRE, "agent");
            xb_add(&bar[XB_XGEN(b.x)], 1u);
            asm volatile("s_waitcnt vmcnt(0)" ::: "memory");
        } else {
            XB_SPIN(xb_ld(&bar[XB_XGEN(b.x)]) == gen, bar);
            __builtin_amdgcn_fence(__ATOMIC_ACQUIRE, "agent");
            asm volatile("s_waitcnt vmcnt(0)" ::: "memory");
        }
    }
    __syncthreads();
}
constexpr size_t WS_BAR = 768 * 1024;
constexpr int LDS_BARST = 151552;

typedef const __attribute__((address_space(4))) Args* ArgsP;
__device__ __forceinline__ const Args& fresh_args() { ArgsP p = (ArgsP)__builtin_amdgcn_kernarg_segment_ptr(); asm volatile("" : "+s"(p)); return *(const Args*)p; }
#define a (fresh_args())
#define GSYNC() do { for (int _r = 0; _r < REP_SYNC; ++_r) { XcdBarrier _b; _b.bar = (unsigned*)(a.ws + WS_BAR); _b.x = xb_xcc_id(); _b.st = (volatile LAS unsigned*)((LAS unsigned char*)lds + LDS_BARST); xcd_barrier(_b); } } while (0)
template <int layer>
__device__ __forceinline__ void layer_body(unsigned char* lds) {

#pragma unroll 1
        for (int rep = 0; rep < REP_GEMM; ++rep) {
            pg8::Gemm g{(const bf16_t*)(a.ws + WS_H), (const bf16_t*)(a.ws + WS_H), (const bf16_t*)(a.ws + WS_WIN + layer * WIN_BYTES), NTOK, NIN, 1024, 1 << 30};
            pg8::StaticOrder S; S.init(NTOK, NIN, (int)gridDim.x, (int)blockIdx.x);
            pg8::EpiIn E{(bf16_t*)(a.ws + WS_U), (float*)(a.ws + WS_DT)};
            pg8::gemm_phase<pg8::EpiIn, pg8::StaticOrder>((LAS unsigned char*)lds, g, S, E);
        }
        GSYNC();
#pragma unroll 1
        for (int rep = 0; rep < REP_SSD; ++rep) phaseB1(a, lds, layer);
#pragma unroll 1
        for (int rep = 0; rep < REP_MISC; ++rep) phaseConf(a, lds, layer);
        GSYNC();
        phaseScan(a, layer);
        GSYNC();
#pragma unroll 1
        for (int rep = 0; rep < REP_SSD; ++rep) phaseB3(a, lds, layer);
        GSYNC();
#pragma unroll 1
        for (int rep = 0; rep < REP_GEMM; ++rep) {
            pg8::Gemm g{(const bf16_t*)(a.ws + WS_YS), (const bf16_t*)(a.ws + WS_YC), (const bf16_t*)(a.ws + WS_WOUT + layer * WOUT_BYTES), NTOK, 2048, 1024, 4};
            pg8::StaticOrder S; S.init(NTOK, 2048, (int)gridDim.x, (int)blockIdx.x);
            pg8::EpiOut E{(bf16_t*)(a.ws + WS_OUT)};
            pg8::gemm_phase<pg8::EpiOut, pg8::StaticOrder>((LAS unsigned char*)lds, g, S, E);
        }
        GSYNC();
        phaseE(a, layer);
        if (layer == 0) GSYNC();
}
__global__ void __launch_bounds__(512, 2) fwd_megakernel(Args a_unused) {
    extern __shared__ __attribute__((aligned(16))) unsigned char lds[];
    cg::grid_group grid = cg::this_grid();
    if (a.ws == nullptr) grid.sync();
    if (threadIdx.x < 2) ((volatile LAS unsigned*)((LAS unsigned char*)lds + LDS_BARST))[threadIdx.x] = 0u;
    __syncthreads();
    (void)xcd_barrier_post((unsigned*)(a.ws + WS_BAR), (volatile LAS unsigned*)((LAS unsigned char*)lds + LDS_BARST));
    for (int rep = 0; rep < REP_MISC; ++rep) phase0(a, lds);
    GSYNC();
    for (int rep = 0; rep < REP_MISC; ++rep) phase1(a);
    GSYNC();
    layer_body<0>(lds);
    layer_body<1>(lds);
}
#undef a
extern "C" void kernel_launch(void* const* d_in, const int* in_sizes, int n_in, void* d_out, int out_size, void* d_ws, size_t ws_size, hipStream_t stream) {
    static int grid = 0;
    if (grid == 0) {
        int dev = 0, cus = 0, per_cu = 0;
        (void)hipGetDevice(&dev);
        (void)hipDeviceGetAttribute(&cus, hipDeviceAttributeMultiprocessorCount, dev);
        (void)hipFuncSetAttribute((const void*)fwd_megakernel, hipFuncAttributeMaxDynamicSharedMemorySize, LDS_BYTES);
        (void)hipOccupancyMaxActiveBlocksPerMultiprocessor(&per_cu, (const void*)fwd_megakernel, 512, LDS_BYTES);
        (void)hipGetLastError();
        if (per_cu < 1) fprintf(stderr, "kernel_launch: occupancy query reports %d blocks/CU\n", per_cu);
        grid = cus > 0 ? cus : 256;
    }
    Args a{};
    const float** f = (const float**)&a;
    for (int i = 0; i < 21; ++i) f[i] = (const float*)d_in[i];
    a.out = (float*)d_out; a.ws = (unsigned char*)d_ws;
    (void)hipMemsetAsync((unsigned char*)d_ws + WS_BAR, 0, XCD_BAR_WORDS * 4, stream);
    void* args[] = {&a};
    hipError_t e = hipLaunchCooperativeKernel((void*)fwd_megakernel, dim3(grid), dim3(512), args, LDS_BYTES, stream);
    if (e != hipSuccess) fprintf(stderr, "cooperative launch failed: %s (grid %d)\n", hipGetErrorString(e), grid);
}
```

```cpp
#include <hip/hip_runtime.h>
#include <hip/hip_cooperative_groups.h>
#include <cstdio>
namespace cg = cooperative_groups;
#ifndef REP_GEMM
#define REP_GEMM 1
#endif
#ifndef REP_SYNC
#define REP_SYNC 1
#endif
#ifndef REP_SSD
#define REP_SSD 1
#endif
#ifndef REP_MISC
#define REP_MISC 1
#endif

#define LAS __attribute__((address_space(3)))
typedef unsigned short bf16_t;
typedef short bf16x8 __attribute__((ext_vector_type(8)));
typedef float f32x4 __attribute__((ext_vector_type(4)));
typedef float f32x2 __attribute__((ext_vector_type(2)));
typedef unsigned u32x4 __attribute__((ext_vector_type(4)));
typedef unsigned u32x2 __attribute__((ext_vector_type(2)));

constexpr int DM = 1024, NTOK = 8192, NCTXTOK = 4096;
constexpr int UC = 5632;
constexpr int NIN = 5888;
constexpr int INCOLS = 5664;
constexpr int U_Z = 0, U_X = 1024, U_B = 2048, U_C = 2176, U_GA = 2560, U_GB = 3584, U_GS = 4608;
constexpr float EPSF = 1e-6f;
constexpr unsigned U_PSTRIDE = 8192u * 512u + 36864u;
__host__ __device__ __forceinline__ unsigned uoff(unsigned row, unsigned col) { return (col >> 8) * U_PSTRIDE + row * 512u + (col & 255u) * 2u; }
constexpr size_t MiB = 1u << 20;
constexpr size_t WS_MOD = 0, WS_TOT = 256 * 1024, WS_SSQ = 512 * 1024;
constexpr size_t WS_WIN = 1 * MiB, WIN_BYTES = (size_t)NIN * 1024 * 2;
constexpr size_t WS_WOUT = 24 * MiB, WOUT_BYTES = (size_t)2048 * 1024 * 2;
constexpr size_t WS_H = 32 * MiB, WS_U = 48 * MiB, WS_OUT = 48 * MiB, WS_DT = 250 * MiB, WS_YS = 137 * MiB, WS_YC = 153 * MiB, WS_ST = 169 * MiB;
constexpr size_t WS_SINL = 32 * MiB  , WS_SINC = 234 * MiB;
constexpr int LDS_BYTES = 155648;

struct Args {
    const float *x_prompt, *x_sample, *state_ssd, *c, *c_ctx, *w_mod, *b_mod, *g_pre, *g_post, *w_in, *ssd_conv_w, *ssd_conv_b, *a_log, *dt_bias, *ssd_d, *ssd_norm_g,
        *conf_conv_w, *conf_conv_b, *conf_ln_g, *conf_ln_b, *w_out;
    float* out; unsigned char* ws;
};

__device__ __forceinline__ int ltid() { int t = (int)threadIdx.x; asm volatile("" : "+v"(t)); return t; }
typedef __bf16 bf16x2v __attribute__((ext_vector_type(2)));
__device__ __forceinline__ unsigned cvt_pk_bf16(float lo, float hi) { const f32x2 v = {lo, hi}; const bf16x2v b = __builtin_convertvector(v, bf16x2v); return __builtin_bit_cast(unsigned, b); }
__device__ __forceinline__ float bf_lo(unsigned w) { return __uint_as_float(w << 16); }
__device__ __forceinline__ float bf_hi(unsigned w) { return __uint_as_float(w & 0xffff0000u); }
__device__ __forceinline__ float silu_f(float v) { return v * __builtin_amdgcn_rcpf(1.f + __expf(-v)); }
__device__ __forceinline__ float sigmoid_f(float v) { return __builtin_amdgcn_rcpf(1.f + __expf(-v)); }
__device__ __forceinline__ float softplus_f(float v) { return fmaxf(v, 0.f) + log1pf(__expf(-fabsf(v))); }
__device__ __forceinline__ float wave_sum(float v) {
#pragma unroll
    for (int o = 1; o < 64; o <<= 1) v += __shfl_xor(v, o);
    return v;
}

namespace pg8 {
constexpr int BM = 256, BK = 64, HALF = 128, HTB = HALF * BK * 2, STAGE_BYTES = 8 * HTB, NXCD = 8, WGM = 8;
__host__ __device__ __forceinline__ int lds_byte(int r, int c) { const int st = (r >> 4) * 2 + (c >> 5), rr = r & 15, cc = c & 31, ob = rr * 64 + cc * 2; return st * 1024 + (ob ^ (((ob >> 9) & 1) << 5)); }
__host__ __device__ __forceinline__ void stage_rc(int b, int& R, int& C) { const int st = b / 1024, sb = b % 1024, swz = sb ^ (((sb >> 9) & 1) << 5); R = (st >> 1) * 16 + swz / 64; C = (st & 1) * 32 + (swz % 64) / 2; }
__host__ __device__ __forceinline__ int perm32(int rho) { const int n = rho >> 4, i = rho & 15; return 8 * (i >> 2) + 4 * n + (i & 3); }
struct Unit { int pm, pn; };
struct Gemm { const bf16_t* A; const bf16_t* A2; const bf16_t* Bt; int M, N, K, split; };
struct StaticOrder {
    int nM, nN, nwg, G, c;
    __device__ void init(int M, int N, int G_, int c_) { nM = M / BM; nN = N / BM; nwg = nM * nN; G = G_; c = c_; }
    __device__ bool next(int i, Unit& u) const {
        const long L = (long)i * G + c; if (L >= nwg) return false;
        int wgid = (int)L; { const int q = nwg / NXCD, r = nwg % NXCD, xcd = wgid % NXCD, off = wgid / NXCD; wgid = (xcd < r ? xcd * (q + 1) : r * (q + 1) + (xcd - r) * q) + off; }
        const int nig = WGM * nN, gid = wgid / nig, fm = gid * WGM, gsz = (nM - fm) < WGM ? (nM - fm) : WGM;
        u.pm = fm + ((wgid % nig) % gsz); u.pn = (wgid % nig) / gsz; return true;
    }
};

struct EpiIn {
    static constexpr bool PERM = true;
    bf16_t* U; float* DT;
    __device__ __forceinline__ void operator()(const f32x4 (&acc)[2][2][4][2], const Unit& u, int wr, int wc, int fr, int fq) const {
        const int row0 = u.pm * BM + wr * 64 + fr;
        if (u.pn >= 10 && u.pn < 18) {
            const int col0 = U_GA + (u.pn - 10) * 128 + wc * 32 + 8 * fq;
#pragma unroll
            for (int ai = 0; ai < 2; ++ai)
#pragma unroll
                for (int m = 0; m < 4; ++m) { bf16_t* rowp = (bf16_t*)((char*)U + uoff((unsigned)(row0 + ai * HALF + m * 16), (unsigned)col0));
                    f32x4 v0, v1;
#pragma unroll
                    for (int e = 0; e < 4; ++e) { v0[e] = acc[ai][0][m][0][e] * sigmoid_f(acc[ai][1][m][0][e]); v1[e] = acc[ai][0][m][1][e] * sigmoid_f(acc[ai][1][m][1][e]); }
                    u32x4 w; w.x = cvt_pk_bf16(v0[0], v0[1]); w.y = cvt_pk_bf16(v0[2], v0[3]); w.z = cvt_pk_bf16(v1[0], v1[1]); w.w = cvt_pk_bf16(v1[2], v1[3]);
                    *(u32x4*)(rowp) = w; }
        } else if (u.pn < 22) {
            const bool act = (u.pn < 4) || (u.pn >= 18);
            const int col0 = (u.pn < 10 ? u.pn * BM : U_GS + (u.pn - 18) * BM) + wc * 32 + 8 * fq;
#pragma unroll
            for (int ai = 0; ai < 2; ++ai)
#pragma unroll
                for (int m = 0; m < 4; ++m) { bf16_t* rowp = (bf16_t*)((char*)U + uoff((unsigned)(row0 + ai * HALF + m * 16), (unsigned)col0));
#pragma unroll
                    for (int bj = 0; bj < 2; ++bj) { f32x4 v0 = acc[ai][bj][m][0], v1 = acc[ai][bj][m][1];
                        if (act) {
#pragma unroll
                            for (int e = 0; e < 4; ++e) { v0[e] = silu_f(v0[e]); v1[e] = silu_f(v1[e]); } }
                        u32x4 w; w.x = cvt_pk_bf16(v0[0], v0[1]); w.y = cvt_pk_bf16(v0[2], v0[3]); w.z = cvt_pk_bf16(v1[0], v1[1]); w.w = cvt_pk_bf16(v1[2], v1[3]);
                        *(u32x4*)(rowp + bj * HALF) = w; } }
        } else if (wc == 0) {
#pragma unroll
            for (int ai = 0; ai < 2; ++ai)
#pragma unroll
                for (int m = 0; m < 4; ++m) { float* rowp = DT + (size_t)(row0 + ai * HALF + m * 16) * 32 + 8 * fq;
                    *(f32x4*)(rowp) = acc[ai][0][m][0]; *(f32x4*)(rowp + 4) = acc[ai][0][m][1]; }
        }
    }
};
struct EpiOut {
    static constexpr bool PERM = true;
    bf16_t* O;
    __device__ __forceinline__ void operator()(const f32x4 (&acc)[2][2][4][2], const Unit& u, int wr, int wc, int fr, int fq) const {
        const int row0 = u.pm * BM + wr * 64 + fr, col0 = u.pn * BM + wc * 32 + 8 * fq;
#pragma unroll
        for (int ai = 0; ai < 2; ++ai)
#pragma unroll
            for (int m = 0; m < 4; ++m) { const int row = row0 + ai * HALF + m * 16;
                bf16_t* rowp = O + (size_t)row * 2048 + col0;
#pragma unroll
                for (int bj = 0; bj < 2; ++bj) { const f32x4 v0 = acc[ai][bj][m][0], v1 = acc[ai][bj][m][1];
                    u32x4 w; w.x = cvt_pk_bf16(v0[0], v0[1]); w.y = cvt_pk_bf16(v0[2], v0[3]); w.z = cvt_pk_bf16(v1[0], v1[1]); w.w = cvt_pk_bf16(v1[2], v1[3]);
                    *(u32x4*)(rowp + bj * HALF) = w; } }
    }
};

template <class Epi, class Sched>
__device__ __forceinline__ void gemm_phase(LAS unsigned char* lds, const Gemm g, const Sched& S, const Epi& E) {
    const int tid = ltid(), wid = __builtin_amdgcn_readfirstlane(tid >> 6), lane = tid & 63, wr = wid >> 2, wc = wid & 3, fr = lane & 15, fq = lane >> 4;
    const int K = g.K, nt = K / BK;
    unsigned voffA[2], voffB[2];
#pragma unroll
    for (int i = 0; i < 2; ++i) { int R, C; stage_rc(tid * 16 + i * 8192, R, C); const int Rb = Epi::PERM ? ((R & ~31) + perm32(R & 31)) : R;
        voffA[i] = (unsigned)(R * K + C) * 2u; voffB[i] = (unsigned)(Rb * K + C) * 2u; }
    const size_t kstep = (size_t)(BK * 2);
    const size_t hstep = (size_t)HALF * K * 2;
    const size_t tstep = 2 * hstep;
    const unsigned ldsw = (unsigned)wid * 1024u;
    const int aoff = lds_byte(wr * 64 + fr, fq * 8), boff = lds_byte(wc * 32 + fr, fq * 8);
#define PG8_SA(b, h) (((b) * 2 + (h)) * HTB)
#define PG8_SB(b, h) ((4 + (b) * 2 + (h)) * HTB)
#define PG8_STAGE(bufoff, gbase, voff) do { _Pragma("unroll") for (int _i = 0; _i < 2; ++_i) \
        __builtin_amdgcn_global_load_lds((const unsigned*)((const char*)(gbase) + (voff)[_i]), (LAS unsigned*)(lds + (bufoff) + ldsw + _i * 8192), 16, 0, 0); } while (0)
#define PG8_LDA(dst, b, h) do { _Pragma("unroll") for (int m = 0; m < 4; ++m) _Pragma("unroll") for (int k = 0; k < 2; ++k) dst[m][k] = *(const LAS bf16x8*)(lds + PG8_SA(b, h) + aoff + m * 2048 + k * 1024); } while (0)
#define PG8_LDB(dst, b, h) do { _Pragma("unroll") for (int n = 0; n < 2; ++n) _Pragma("unroll") for (int k = 0; k < 2; ++k) dst[n][k] = *(const LAS bf16x8*)(lds + PG8_SB(b, h) + boff + n * 2048 + k * 1024); } while (0)
#define PG8_MMA(ai, bj, At, Bt) do { __builtin_amdgcn_s_setprio(1); _Pragma("unroll") for (int m = 0; m < 4; ++m) _Pragma("unroll") for (int n = 0; n < 2; ++n) _Pragma("unroll") for (int k = 0; k < 2; ++k) \
        acc[ai][bj][m][n] = __builtin_amdgcn_mfma_f32_16x16x32_bf16(Bt[n][k], At[m][k], acc[ai][bj][m][n], 0, 0, 0); __builtin_amdgcn_s_setprio(0); } while (0)
#define PG8_WAIT_V(n) asm volatile("s_waitcnt vmcnt(" #n ")" ::: "memory")
#define PG8_WAIT_L(n) asm volatile("s_waitcnt lgkmcnt(" #n ")" ::: "memory")
#define PG8_BAR __builtin_amdgcn_s_barrier()
#define PG8_SCHED __builtin_amdgcn_sched_barrier(0)
    Unit cur, nxt; int ui = 0;
    if (!S.next(0, cur)) return;
    f32x4 acc[2][2][4][2];
#pragma unroll
    for (int a = 0; a < 2; ++a)
#pragma unroll
        for (int b = 0; b < 2; ++b)
#pragma unroll
            for (int m = 0; m < 4; ++m)
#pragma unroll
                for (int n = 0; n < 2; ++n) acc[a][b][m][n] = (f32x4){0.f, 0.f, 0.f, 0.f};
    bf16x8 At[4][2], B0[2][2], B1[2][2];
    const char* cA = (const char*)(cur.pn >= g.split ? g.A2 : g.A) + (size_t)cur.pm * tstep; const char* cB = (const char*)g.Bt + (size_t)cur.pn * tstep;
    PG8_STAGE(PG8_SB(0, 0), cB, voffB); PG8_STAGE(PG8_SA(0, 0), cA, voffA); PG8_STAGE(PG8_SB(0, 1), cB + hstep, voffB); PG8_STAGE(PG8_SA(0, 1), cA + hstep, voffA);
    if (wr == 1) PG8_BAR;
    PG8_WAIT_V(4); PG8_BAR;
    PG8_STAGE(PG8_SB(1, 0), cB + kstep, voffB); PG8_STAGE(PG8_SA(1, 0), cA + kstep, voffA); PG8_STAGE(PG8_SB(1, 1), cB + hstep + kstep, voffB);
    PG8_WAIT_V(6); PG8_BAR;
    for (;;) {
        const bool has_next = S.next(ui + 1, nxt);
        const char* nA = has_next ? (const char*)(nxt.pn >= g.split ? g.A2 : g.A) + (size_t)nxt.pm * tstep : cA; const char* nB = has_next ? (const char*)g.Bt + (size_t)nxt.pn * tstep : cB;
        for (int t = 0; t < nt; t += 2) {
            const bool last = (t == nt - 2);
            const char* a1 = cA + (size_t)(t + 1) * kstep;
            const char* a2 = last ? nA : cA + (size_t)(t + 2) * kstep; const char* b2 = last ? nB : cB + (size_t)(t + 2) * kstep;
            const char* a3 = a2 + kstep; const char* b3 = b2 + kstep;
            PG8_LDB(B0, 0, 0); PG8_SCHED; PG8_LDA(At, 0, 0); PG8_STAGE(PG8_SA(1, 1), a1 + hstep, voffA);
            PG8_WAIT_L(8); PG8_BAR; PG8_WAIT_L(0); PG8_MMA(0, 0, At, B0); PG8_BAR; PG8_SCHED;
            PG8_LDB(B1, 0, 1); PG8_STAGE(PG8_SB(0, 0), b2, voffB);
            PG8_BAR; PG8_WAIT_L(0); PG8_MMA(0, 1, At, B1); PG8_BAR;
            PG8_LDA(At, 0, 1); PG8_STAGE(PG8_SA(0, 0), a2, voffA);
            PG8_BAR; PG8_WAIT_L(0); PG8_MMA(1, 0, At, B0); PG8_BAR; PG8_SCHED;
            PG8_STAGE(PG8_SB(0, 1), b2 + hstep, voffB);
            PG8_WAIT_V(6); PG8_BAR; PG8_MMA(1, 1, At, B1); PG8_BAR;
            PG8_LDB(B0, 1, 0); PG8_SCHED; PG8_LDA(At, 1, 0); PG8_STAGE(PG8_SA(0, 1), a2 + hstep, voffA);
            PG8_WAIT_L(8); PG8_BAR; PG8_WAIT_L(0); PG8_MMA(0, 0, At, B0); PG8_BAR; PG8_SCHED;
            PG8_LDB(B1, 1, 1); PG8_STAGE(PG8_SB(1, 0), b3, voffB);
            PG8_BAR; PG8_WAIT_L(0); PG8_MMA(0, 1, At, B1); PG8_BAR;
            PG8_LDA(At, 1, 1); PG8_STAGE(PG8_SA(1, 0), a3, voffA);
            PG8_BAR; PG8_WAIT_L(0); PG8_MMA(1, 0, At, B0); PG8_BAR; PG8_SCHED;
            PG8_STAGE(PG8_SB(1, 1), b3 + hstep, voffB);
            PG8_WAIT_V(6); PG8_BAR; PG8_MMA(1, 1, At, B1); PG8_BAR;
        }
        E(acc, cur, wr, wc, fr, fq);
        if (!has_next) break;
#pragma unroll
        for (int a = 0; a < 2; ++a)
#pragma unroll
            for (int b = 0; b < 2; ++b)
#pragma unroll
                for (int m = 0; m < 4; ++m)
#pragma unroll
                    for (int n = 0; n < 2; ++n) acc[a][b][m][n] = (f32x4){0.f, 0.f, 0.f, 0.f};
        cur = nxt; cA = nA; cB = nB; ++ui;
    }
    PG8_WAIT_V(0);
    if (wr == 0) PG8_BAR;
    PG8_BAR;
#undef PG8_SA
#undef PG8_SB
#undef PG8_STAGE
#undef PG8_LDA
#undef PG8_LDB
#undef PG8_MMA
#undef PG8_WAIT_V
#undef PG8_WAIT_L
#undef PG8_BAR
#undef PG8_SCHED
}
}

__device__ __forceinline__ void p0_transpose_item(const float* W, int Nsrc, int nsrc, int k0src, bf16_t* WT, int Kdst, int ndst0, int k0dst, const float* kscale, float* scr, int lane) {
    float v[64];
    if (nsrc >= 0) {
#pragma unroll
        for (int kk = 0; kk < 64; ++kk) v[kk] = __builtin_nontemporal_load(W + (size_t)(k0src + kk) * Nsrc + nsrc);
    } else {
#pragma unroll
        for (int kk = 0; kk < 64; ++kk) v[kk] = 0.f;
    }
    if (kscale) { const float ks = kscale[k0dst + lane];
#pragma unroll
        for (int kk = 0; kk < 64; ++kk) v[kk] *= __shfl(ks, kk); }
#pragma unroll
    for (int kk = 0; kk < 64; ++kk) scr[kk * 65 + lane] = v[kk];
    asm volatile("s_waitcnt lgkmcnt(0)" ::: "memory");
    const int c = lane & 7;
#pragma unroll
    for (int j = 0; j < 8; ++j) { const int n = (lane >> 3) + 8 * j; const float* s = scr + (8 * c) * 65 + n;
        u32x4 o; o.x = cvt_pk_bf16(s[0 * 65], s[1 * 65]); o.y = cvt_pk_bf16(s[2 * 65], s[3 * 65]); o.z = cvt_pk_bf16(s[4 * 65], s[5 * 65]); o.w = cvt_pk_bf16(s[6 * 65], s[7 * 65]);
        *(u32x4*)(WT + (size_t)(ndst0 + n) * Kdst + k0dst + 8 * c) = o; }
    asm volatile("s_waitcnt lgkmcnt(0)" ::: "memory");
}

__device__ __forceinline__ void phase0(const Args& a, unsigned char* lds) {
    const int tid = ltid(), lane = tid & 63, wave = tid >> 6;
    for (int unit = blockIdx.x; unit < 96; unit += gridDim.x) {
        const int l = unit / 48, jb = unit % 48;
        float cv[3][2];
#pragma unroll
        for (int r = 0; r < 3; ++r) { const float* src = (r == 0) ? a.c_ctx : a.c + (r - 1) * 1024;
#pragma unroll
            for (int t = 0; t < 2; ++t) cv[r][t] = silu_f(src[128 * wave + 64 * t + lane]); }
        float acc0 = 0.f, acc1 = 0.f, acc2 = 0.f;
        const float* W = a.w_mod + (size_t)l * 1024 * 3072 + (size_t)(128 * wave) * 3072 + 64 * jb + lane;
#pragma unroll
        for (int t = 0; t < 2; ++t) {
#pragma unroll 32
            for (int kk = 0; kk < 64; ++kk) { const float wv = W[(size_t)(64 * t + kk) * 3072];
                acc0 += __shfl(cv[0][t], kk) * wv; acc1 += __shfl(cv[1][t], kk) * wv; acc2 += __shfl(cv[2][t], kk) * wv; }
        }
        float* red = (float*)lds;
        red[(wave * 3 + 0) * 64 + lane] = acc0; red[(wave * 3 + 1) * 64 + lane] = acc1; red[(wave * 3 + 2) * 64 + lane] = acc2;
        __syncthreads();
        if (wave < 3) { float s = 0.f;
#pragma unroll
            for (int w = 0; w < 8; ++w) s += red[(w * 3 + wave) * 64 + lane];
            ((float*)(a.ws + WS_MOD))[(l * 3 + wave) * 3072 + 64 * jb + lane] = s + a.b_mod[l * 3072 + 64 * jb + lane]; }
        __syncthreads();
    }
    float* scr = (float*)(lds + 8192 + wave * 16640);
    const int gw = blockIdx.x * 8 + wave, NGW = gridDim.x * 8;
    constexpr int I_IN = 16 * (NIN / 64), I_OUT = 2 * 16 * 16, I_L = I_IN + I_OUT;
    for (int it = gw; it < 2 * I_L; it += NGW) {
        const int l = it / I_L; int r = it % I_L;
        if (r < I_IN) {
            const int kb = r / (NIN / 64), nb = r % (NIN / 64), n0 = nb * 64;
            int ns;
            if (n0 < 2048) ns = n0 + lane;
            else if (n0 < 2560) { const int gg = (n0 - 2048) >> 8, rr = (n0 - 2048) & 255; ns = ((rr < 128) ? 2048 + 128 * gg + rr : 2304 + 128 * gg + (rr - 128)) + lane; }
            else if (n0 < 4608) { const int t = (n0 - 2560) >> 8, rr = (n0 - 2560) & 255; ns = ((rr < 128) ? 2592 + 128 * t + rr : 3616 + 128 * t + (rr - 128)) + lane; }
            else if (n0 < 5632) ns = n0 + 32 + lane;
            else if (n0 == 5632) ns = (lane < 32) ? 2560 + lane : -1;
            else ns = -1;
            p0_transpose_item(a.w_in + (size_t)l * 1024 * INCOLS, INCOLS, ns, kb * 64, (bf16_t*)(a.ws + WS_WIN + l * WIN_BYTES), 1024, n0, kb * 64, nullptr, scr, lane);
        } else {
            r -= I_IN; const int half = r / 256; r %= 256; const int kb = r / 16, nb = r % 16;
            p0_transpose_item(a.w_out + (size_t)l * 2048 * 1024, 1024, nb * 64 + lane, half * 1024 + kb * 64, (bf16_t*)(a.ws + WS_WOUT + l * WOUT_BYTES), 1024, half * 1024 + nb * 64, kb * 64,
                              half == 0 ? a.ssd_norm_g + l * 1024 : nullptr, scr, lane);
        }
    }
}

__device__ __forceinline__ void normmod_row(const f32x4 (&v)[4], const Args& a, int layer, int rg, bf16_t* hrow, int lane) {
    float s = 0.f;
#pragma unroll
    for (int j = 0; j < 4; ++j) s += (v[j][0] * v[j][0] + v[j][1] * v[j][1]) + (v[j][2] * v[j][2] + v[j][3] * v[j][3]);
    const float r = rsqrtf(wave_sum(s) * (1.f / 1024.f) + EPSF);
    const float* mod = (const float*)(a.ws + WS_MOD) + (size_t)(layer * 3 + rg) * 3072;
#pragma unroll
    for (int j = 0; j < 4; ++j) { const int c0 = 4 * lane + 256 * j;
        const f32x4 g = *(const f32x4*)(a.g_pre + layer * 1024 + c0), sh = *(const f32x4*)(mod + c0), sc = *(const f32x4*)(mod + 1024 + c0);
        f32x4 h;
#pragma unroll
        for (int e = 0; e < 4; ++e) h[e] = v[j][e] * r * g[e] * (1.f + sc[e]) + sh[e];
        u32x2 o; o.x = cvt_pk_bf16(h[0], h[1]); o.y = cvt_pk_bf16(h[2], h[3]);
        *(u32x2*)(hrow + c0) = o; }
}
__device__ __forceinline__ void normmod_row_pre(const f32x4 (&v)[4], const f32x4 (&g)[4], const f32x4 (&sh)[4], const f32x4 (&sc)[4], bf16_t* hrow, int lane) {
    float s = 0.f;
#pragma unroll
    for (int j = 0; j < 4; ++j) s += (v[j][0] * v[j][0] + v[j][1] * v[j][1]) + (v[j][2] * v[j][2] + v[j][3] * v[j][3]);
    const float r = rsqrtf(wave_sum(s) * (1.f / 1024.f) + EPSF);
#pragma unroll
    for (int j = 0; j < 4; ++j) { const int c0 = 4 * lane + 256 * j;
        f32x4 h;
#pragma unroll
        for (int e = 0; e < 4; ++e) h[e] = v[j][e] * r * g[j][e] * (1.f + sc[j][e]) + sh[j][e];
        u32x2 o; o.x = cvt_pk_bf16(h[0], h[1]); o.y = cvt_pk_bf16(h[2], h[3]);
        *(u32x2*)(hrow + c0) = o; }
}
__device__ __forceinline__ int row_group(int row) { return row < NCTXTOK ? 0 : 1 + ((row - NCTXTOK) >> 11); }

__device__ __forceinline__ void phase1(const Args& a) {
    const int lane = ltid() & 63, gw = blockIdx.x * 8 + (ltid() >> 6), NGW = gridDim.x * 8;
    for (int row0 = 2 * gw; row0 < NTOK; row0 += 2 * NGW) {
        f32x4 v[2][4];
        const float* m0 = (const float*)(a.ws + WS_MOD) + (size_t)row_group(row0) * 3072;
        f32x4 g0v[4], sh0v[4], sc0v[4];
#pragma unroll
        for (int j = 0; j < 4; ++j) { const int c0 = 4 * lane + 256 * j; g0v[j] = *(const f32x4*)(a.g_pre + c0); sh0v[j] = *(const f32x4*)(m0 + c0); sc0v[j] = *(const f32x4*)(m0 + 1024 + c0); }
#pragma unroll
        for (int t = 0; t < 2; ++t) { const int row = row0 + t;
            if (row < NTOK) { const float* xr = (row < NCTXTOK) ? a.x_prompt + (size_t)row * 1024 : a.x_sample + (size_t)(row - NCTXTOK) * 1024;
#pragma unroll
                for (int j = 0; j < 4; ++j) v[t][j] = *(const f32x4*)(xr + 4 * lane + 256 * j); } }
#pragma unroll
        for (int t = 0; t < 2; ++t) { const int row = row0 + t;
            if (row < NTOK) normmod_row_pre(v[t], g0v, sh0v, sc0v, (bf16_t*)(a.ws + WS_H) + (size_t)row * 1024, lane); }
    }
}

__device__ __forceinline__ void phaseE(const Args& a, int layer) {
    const int lane = ltid() & 63, gw = blockIdx.x * 8 + (ltid() >> 6), NGW = gridDim.x * 8;
    const bf16_t* O = (const bf16_t*)(a.ws + WS_OUT);
    for (int row0 = 2 * gw; row0 < NTOK; row0 += 2 * NGW) {
        u32x2 pb[2][4], qb[2][4]; f32x4 xv[2][4]; int rows[2]; bool have[2]; float sqv[2];
        const int rgp = row_group(row0);
        const float* modp = (const float*)(a.ws + WS_MOD) + (size_t)(layer * 3 + rgp) * 3072;
        f32x4 gpv[4], gtv[4], g1v[4], sh1v[4], sc1v[4];
#pragma unroll
        for (int j = 0; j < 4; ++j) { const int c0 = 4 * lane + 256 * j; gpv[j] = *(const f32x4*)(a.g_post + layer * 1024 + c0); gtv[j] = *(const f32x4*)(modp + 2048 + c0);
            if (layer == 0) { const float* m1 = (const float*)(a.ws + WS_MOD) + (size_t)(3 + rgp) * 3072; g1v[j] = *(const f32x4*)(a.g_pre + 1024 + c0); sh1v[j] = *(const f32x4*)(m1 + c0); sc1v[j] = *(const f32x4*)(m1 + 1024 + c0); } }
#pragma unroll
        for (int t = 0; t < 2; ++t) { const int row = row0 + t; rows[t] = row; have[t] = row < NTOK; sqv[t] = 0.f;
            if (have[t]) {
                sqv[t] = ((const float*)(a.ws + WS_SSQ))[(size_t)row * 4 + (lane & 3)];
                const float* xr = (layer == 0) ? ((row < NCTXTOK) ? a.x_prompt + (size_t)row * 1024 : a.x_sample + (size_t)(row - NCTXTOK) * 1024) : a.out + (size_t)row * 1024;
#pragma unroll
                for (int j = 0; j < 4; ++j) { const int c0 = 4 * lane + 256 * j; pb[t][j] = __builtin_nontemporal_load((const u32x2*)(O + (size_t)row * 2048 + c0)); qb[t][j] = __builtin_nontemporal_load((const u32x2*)(O + (size_t)row * 2048 + 1024 + c0)); xv[t][j] = __builtin_nontemporal_load((const f32x4*)(xr + c0)); } } }
        f32x4 o[2][4]; float ssum[2], ssum2[2];
#pragma unroll
        for (int t = 0; t < 2; ++t) {
            float sq = sqv[t]; sq += __shfl_xor(sq, 1); sq += __shfl_xor(sq, 2);
            const float rsn = rsqrtf(sq * (1.f / 1024.f) + EPSF);
            float s = 0.f;
#pragma unroll
            for (int j = 0; j < 4; ++j) { const u32x2 p2 = pb[t][j], q2 = qb[t][j];
                o[t][j] = (f32x4){rsn * bf_lo(p2.x) + bf_lo(q2.x), rsn * bf_hi(p2.x) + bf_hi(q2.x), rsn * bf_lo(p2.y) + bf_lo(q2.y), rsn * bf_hi(p2.y) + bf_hi(q2.y)};
                s += (o[t][j][0] * o[t][j][0] + o[t][j][1] * o[t][j][1]) + (o[t][j][2] * o[t][j][2] + o[t][j][3] * o[t][j][3]); }
            ssum[t] = s; }
#pragma unroll
        for (int sh = 1; sh < 64; sh <<= 1) { const float t0 = __shfl_xor(ssum[0], sh), t1 = __shfl_xor(ssum[1], sh); ssum[0] += t0; ssum[1] += t1; }
#pragma unroll
        for (int t = 0; t < 2; ++t) { const float r = rsqrtf(ssum[t] * (1.f / 1024.f) + EPSF); float s2 = 0.f;
#pragma unroll
            for (int j = 0; j < 4; ++j) { const f32x4 gp = gpv[j], gt = gtv[j];
#pragma unroll
                for (int e = 0; e < 4; ++e) xv[t][j][e] = xv[t][j][e] + gt[e] * (o[t][j][e] * r * gp[e]);
                s2 += (xv[t][j][0] * xv[t][j][0] + xv[t][j][1] * xv[t][j][1]) + (xv[t][j][2] * xv[t][j][2] + xv[t][j][3] * xv[t][j][3]);
                if (have[t]) __builtin_nontemporal_store(xv[t][j], (f32x4*)(a.out + (size_t)rows[t] * 1024 + 4 * lane + 256 * j)); }
            ssum2[t] = s2; }
        if (layer == 0) {
#pragma unroll
            for (int sh = 1; sh < 64; sh <<= 1) { const float t0 = __shfl_xor(ssum2[0], sh), t1 = __shfl_xor(ssum2[1], sh); ssum2[0] += t0; ssum2[1] += t1; }
#pragma unroll
            for (int t = 0; t < 2; ++t) if (have[t]) { const float r1 = rsqrtf(ssum2[t] * (1.f / 1024.f) + EPSF); bf16_t* hrow = (bf16_t*)(a.ws + WS_H) + (size_t)rows[t] * 1024;
#pragma unroll
                for (int j = 0; j < 4; ++j) { const int c0 = 4 * lane + 256 * j; f32x4 h;
#pragma unroll
                    for (int e = 0; e < 4; ++e) h[e] = xv[t][j][e] * r1 * g1v[j][e] * (1.f + sc1v[j][e]) + sh1v[j][e];
                    u32x2 ob; ob.x = cvt_pk_bf16(h[0], h[1]); ob.y = cvt_pk_bf16(h[2], h[3]);
                    *(u32x2*)(hrow + c0) = ob; } }
        }
    }
}

__device__ __forceinline__ int vblock() { const int G = gridDim.x, bx = blockIdx.x; return (G % 8 == 0) ? (bx % 8) * (G / 8) + bx / 8 : bx; }
constexpr int XT_OFF = 0, XT_PITCH = 272, CN_OFF = 69632, BN_OFF = 104448, QA_OFF = 139264, DTA_OFF = 143360, SCA_OFF = 147456;
constexpr int YL_PITCH = 260;

struct SsdUnit { int cu, g, hh, row0, tl0, L; bool ctx; int c; };
__device__ __forceinline__ SsdUnit ssd_unit(int u) {
    SsdUnit s; s.cu = u >> 2; s.g = (u >> 1) & 1; s.hh = u & 1;
    if (s.cu < 32) { s.ctx = true; const int b = s.cu >> 1; s.c = s.cu & 1; s.L = 256; s.row0 = b * 256 + s.c * 128; }
    else { s.ctx = false; const int v = s.cu - 32, b = v >> 4; s.c = v & 15; s.L = 2048; s.row0 = NCTXTOK + b * 2048 + s.c * 128; }
    s.tl0 = s.c * 128; return s;
}

__device__ __forceinline__ f32x2 silu2(f32x2 v) {
    const f32x2 t = v * (-1.44269504f);
    f32x2 e; e[0] = __builtin_amdgcn_exp2f(t[0]); e[1] = __builtin_amdgcn_exp2f(t[1]);
    const f32x2 d = e + 1.0f;
    f32x2 r; r[0] = __builtin_amdgcn_rcpf(d[0]); r[1] = __builtin_amdgcn_rcpf(d[1]);
    return v * r;
}
template <bool BTR, bool NEEDC>
__device__ __forceinline__ void ssd_load_conv(unsigned char* lds, const bf16_t* U, const float* cw, const float* cbias, const SsdUnit& su) {
    const int tid = ltid(), lane = tid & 63, wave = tid >> 6, seg = wave >> 1;
    const int cgi = (wave & 1) * 64 + lane;
    int kind, ucol, cg4;
    if (cgi < 64) { kind = 0; cg4 = cgi; ucol = U_X + (su.g * 8 + su.hh * 4) * 64 + cg4 * 4; }
    else if (cgi < 96) { kind = 1; cg4 = cgi - 64; ucol = U_B + su.g * 256 + cg4 * 4; }
    else { kind = 2; cg4 = cgi - 96; ucol = U_C + su.g * 256 + cg4 * 4; }
    if (!NEEDC && kind == 2) return;
    const int ch = (kind == 0) ? ucol - 1024 : (kind == 1 ? 1024 + su.g * 128 + cg4 * 4 : 1280 + su.g * 128 + cg4 * 4);
    f32x2 w[5][2], bia[2];
#pragma unroll
    for (int k = 0; k < 5; ++k) { const f32x4 w0 = *(const f32x4*)(cw + k * 1536 + ch); w[k][0] = (f32x2){w0[0], w0[1]}; w[k][1] = (f32x2){w0[2], w0[3]}; }
    { const f32x4 b0 = *(const f32x4*)(cbias + ch); bia[0] = (f32x2){b0[0], b0[1]}; bia[1] = (f32x2){b0[2], b0[3]}; }
    const bool transposed = (kind == 0) || (BTR && kind == 1);
    const int seq_row0 = su.row0 - su.tl0;
    u32x2 rawall[36];
#pragma unroll
    for (int i = 0; i < 36; ++i) { int tl = su.tl0 + seg * 32 - 2 + i;
        if (i < 2) tl = tl < 0 ? 0 : tl;
        if (i >= 34) tl = tl >= su.L ? su.L - 1 : tl;
        rawall[i] = *(const u32x2*)((const char*)U + uoff((unsigned)(seq_row0 + tl), (unsigned)ucol)); }
    { const unsigned mlo = (su.tl0 + seg * 32 - 2 < 0) ? 0u : 0xffffffffu, mhi = (su.tl0 + seg * 32 + 34 > su.L) ? 0u : 0xffffffffu;
      rawall[0].x &= mlo; rawall[0].y &= mlo; rawall[1].x &= mlo; rawall[1].y &= mlo;
      rawall[34].x &= mhi; rawall[34].y &= mhi; rawall[35].x &= mhi; rawall[35].y &= mhi; }
#pragma unroll
    for (int sub = 0; sub < 4; ++sub) {
        const int rr = seg * 32 + sub * 8;
        f32x2 o[8][2];
#pragma unroll
        for (int r = 0; r < 8; ++r) { o[r][0] = bia[0]; o[r][1] = bia[1]; }
#pragma unroll
        for (int i = 0; i < 12; ++i) { const u32x2 rw = rawall[sub * 8 + i];
            const f32x2 v0 = (f32x2){bf_lo(rw.x), bf_hi(rw.x)}, v1 = (f32x2){bf_lo(rw.y), bf_hi(rw.y)};
#pragma unroll
            for (int k = 0; k < 5; ++k) { const int r = i - k; if (r >= 0 && r < 8) { o[r][0] = __builtin_elementwise_fma(w[k][0], v0, o[r][0]); o[r][1] = __builtin_elementwise_fma(w[k][1], v1, o[r][1]); } } }
#pragma unroll
        for (int r = 0; r < 8; ++r) { o[r][0] = silu2(o[r][0]); o[r][1] = silu2(o[r][1]); }
        if (transposed) {
            unsigned char* base = lds + (kind == 0 ? XT_OFF : CN_OFF);
            const int chunk = rr >> 3;
#pragma unroll
            for (int e = 0; e < 4; ++e) { const int R = cg4 * 4 + e; const int phys = chunk ^ ((R >> 3) & 3);
                u32x4 pk; pk.x = cvt_pk_bf16(o[0][e >> 1][e & 1], o[1][e >> 1][e & 1]); pk.y = cvt_pk_bf16(o[2][e >> 1][e & 1], o[3][e >> 1][e & 1]);
                pk.z = cvt_pk_bf16(o[4][e >> 1][e & 1], o[5][e >> 1][e & 1]); pk.w = cvt_pk_bf16(o[6][e >> 1][e & 1], o[7][e >> 1][e & 1]);
                *(u32x4*)(base + R * XT_PITCH + phys * 16) = pk; }
        } else {
            unsigned char* base = lds + (kind == 1 ? BN_OFF : CN_OFF);
#pragma unroll
            for (int r = 0; r < 8; ++r) { u32x2 pk; pk.x = cvt_pk_bf16(o[r][0][0], o[r][0][1]); pk.y = cvt_pk_bf16(o[r][1][0], o[r][1][1]);
                *(u32x2*)(base + (rr + r) * XT_PITCH + cg4 * 8) = pk; }
        }
    }
}

__device__ __forceinline__ float ssd_dtq(unsigned char* lds, int slot, const float* DT, int row0, int head, int d, const float* a_log_l, const float* dt_bias_l, bool want_sc) {
    const int lane = ltid() & 63;
    const float bias = dt_bias_l[d * 16 + head], av = -__expf(a_log_l[d * 16 + head]);
    const float r0 = DT[(size_t)(row0 + 2 * lane) * 32 + d * 16 + head], r1 = DT[(size_t)(row0 + 2 * lane + 1) * 32 + d * 16 + head];
    const float dt0 = softplus_f(r0 + bias), dt1 = softplus_f(r1 + bias);
    const float la0 = dt0 * av, la1 = dt1 * av, s = la0 + la1;
    float incl = s;
#pragma unroll
    for (int o = 1; o < 64; o <<= 1) { const float t = __shfl_up(incl, o); if (lane >= o) incl += t; }
    const float tot = __shfl(incl, 63), excl = incl - s;
    float q0, q1;
    if (d == 0) { q0 = excl + la0; q1 = incl; } else { q0 = tot - excl; q1 = tot - excl - la0; }
    float* QA = (float*)(lds + QA_OFF) + slot * 128; float* DTA = (float*)(lds + DTA_OFF) + slot * 128;
    *(f32x2*)(QA + 2 * lane) = (f32x2){q0 * 1.44269504f, q1 * 1.44269504f}; *(f32x2*)(DTA + 2 * lane) = (f32x2){q0 * 1.44269504f - __log2f(dt0), q1 * 1.44269504f - __log2f(dt1)};
    if (want_sc) { float* SCA = (float*)(lds + SCA_OFF) + slot * 128; *(f32x2*)(SCA + 2 * lane) = (f32x2){dt0 * __expf(tot - q0), dt1 * __expf(tot - q1)}; }
    return tot;
}

__device__ __forceinline__ bf16x8 as_bf16x8(u32x4 v) { return __builtin_bit_cast(bf16x8, v); }

__device__ __forceinline__ void phaseB1(const Args& a, unsigned char* lds, int layer) {
    const int tid = ltid(), lane = tid & 63, wave = tid >> 6, fr = lane & 15, fq = lane >> 4;
    const bf16_t* U = (const bf16_t*)(a.ws + WS_U); const float* DT = (const float*)(a.ws + WS_DT);
    float* ST = (float*)(a.ws + WS_ST); float* TOT = (float*)(a.ws + WS_TOT);
    for (int u = vblock(); u < 256; u += gridDim.x) {
        const SsdUnit su = ssd_unit(u);
        const int i = wave >> 1, d = wave & 1, head = su.g * 8 + su.hh * 4 + i;
        const float tot = ssd_dtq(lds, wave, DT, su.row0, head, d, a.a_log + layer * 32, a.dt_bias + layer * 32, true);
        const size_t sidx = (size_t)((su.cu * 16 + head) * 2 + d);
        if (lane == 0) TOT[sidx] = tot;
        ssd_load_conv<true, false>(lds, U, a.ssd_conv_w + (size_t)layer * 5 * 1536, a.ssd_conv_b + layer * 1536, su);
        __syncthreads();
        const float* SCA = (const float*)(lds + SCA_OFF) + wave * 128;
        bf16x8 Af[4][4];
#pragma unroll
        for (int pt = 0; pt < 4; ++pt)
#pragma unroll
            for (int ks = 0; ks < 4; ++ks) { const int R = i * 64 + pt * 16 + fr, chunk = ks * 4 + fq;
                const u32x4 xr = *(const u32x4*)(lds + XT_OFF + R * XT_PITCH + ((chunk ^ ((R >> 3) & 3)) * 16));
                const f32x4 s0 = *(const f32x4*)(SCA + chunk * 8), s1 = *(const f32x4*)(SCA + chunk * 8 + 4);
                u32x4 o; o.x = cvt_pk_bf16(bf_lo(xr.x) * s0[0], bf_hi(xr.x) * s0[1]); o.y = cvt_pk_bf16(bf_lo(xr.y) * s0[2], bf_hi(xr.y) * s0[3]);
                o.z = cvt_pk_bf16(bf_lo(xr.z) * s1[0], bf_hi(xr.z) * s1[1]); o.w = cvt_pk_bf16(bf_lo(xr.w) * s1[2], bf_hi(xr.w) * s1[3]);
                Af[pt][ks] = as_bf16x8(o); }
        float* stp = ST + sidx * 8192;
#pragma unroll 1
        for (int nt = 0; nt < 8; ++nt) {
            f32x4 acc[4];
#pragma unroll
            for (int pt = 0; pt < 4; ++pt) acc[pt] = (f32x4){0.f, 0.f, 0.f, 0.f};
#pragma unroll
            for (int ks = 0; ks < 4; ++ks) { const int n = nt * 16 + fr, chunk = ks * 4 + fq;
                const bf16x8 Bf = *(const bf16x8*)(lds + CN_OFF + n * XT_PITCH + ((chunk ^ ((n >> 3) & 3)) * 16));
#pragma unroll
                for (int pt = 0; pt < 4; ++pt) acc[pt] = __builtin_amdgcn_mfma_f32_16x16x32_bf16(Bf, Af[pt][ks], acc[pt], 0, 0, 0); }
#pragma unroll
            for (int pt = 0; pt < 4; ++pt) {
                if (su.ctx) *(f32x4*)(stp + (pt * 16 + fr) * 128 + nt * 16 + 4 * fq) = acc[pt];
                else { u32x2 o; o.x = cvt_pk_bf16(acc[pt][0], acc[pt][1]); o.y = cvt_pk_bf16(acc[pt][2], acc[pt][3]); *(u32x2*)((bf16_t*)stp + (pt * 16 + fr) * 128 + nt * 16 + 4 * fq) = o; } }
        }
        __syncthreads();
    }
}

__device__ __forceinline__ void phaseScan(const Args& a, int layer) {
    const float* ST = (const float*)(a.ws + WS_ST); const float* TOT = (const float*)(a.ws + WS_TOT);
    bf16_t* SINL = (bf16_t*)(a.ws + WS_SINL); bf16_t* SINC = (bf16_t*)(a.ws + WS_SINC);
    const int gid = blockIdx.x * 512 + ltid(), GT = gridDim.x * 512;
    for (int id = gid; id < 64 * 2048; id += GT) {
        const int chain = id >> 11, e4 = id & 2047, b = chain >> 5, h = (chain >> 1) & 15, d = chain & 1;
        f32x4 S = *(const f32x4*)(a.state_ssd + ((size_t)(((b * 2 + layer) * 2 + d) * 16 + h)) * 8192 + e4 * 4);
        f32x4 t[16]; float dec[16];
#pragma unroll
        for (int s = 0; s < 16; ++s) { const int c = d ? 15 - s : s; const size_t sidx = (size_t)(((32 + b * 16 + c) * 16 + h) * 2 + d);
            const u32x2 tb = __builtin_nontemporal_load((const u32x2*)((const bf16_t*)(ST + sidx * 8192) + e4 * 4)); t[s] = (f32x4){bf_lo(tb.x), bf_hi(tb.x), bf_lo(tb.y), bf_hi(tb.y)}; dec[s] = __expf(TOT[sidx]); }
#pragma unroll
        for (int s = 0; s < 16; ++s) { const int c = d ? 15 - s : s; const size_t lidx = (size_t)(((b * 16 + c) * 16 + h) * 2 + d);
            u32x2 o; o.x = cvt_pk_bf16(S[0], S[1]); o.y = cvt_pk_bf16(S[2], S[3]);
            *(u32x2*)(SINL + lidx * 8192 + e4 * 4) = o; S = S * dec[s] + t[s]; }
    }
    float* ns = a.out + (size_t)NTOK * 1024;
    for (int id = gid; id < 512 * 2048; id += GT) {
        const int chain = id >> 11, e4 = id & 2047, b = chain >> 5, h = (chain >> 1) & 15, d = chain & 1;
        const int c1 = d ? 1 : 0, c2 = d ? 0 : 1;
        const size_t s1 = (size_t)(((b * 2 + c1) * 16 + h) * 2 + d), s2 = (size_t)(((b * 2 + c2) * 16 + h) * 2 + d);
        const f32x4 v1 = __builtin_nontemporal_load((const f32x4*)(ST + s1 * 8192 + e4 * 4)), v2 = __builtin_nontemporal_load((const f32x4*)(ST + s2 * 8192 + e4 * 4));
        u32x2 o; o.x = cvt_pk_bf16(v1[0], v1[1]); o.y = cvt_pk_bf16(v1[2], v1[3]);
        *(u32x2*)(SINC + (size_t)chain * 8192 + e4 * 4) = o;
        *(f32x4*)(ns + ((size_t)(((b * 2 + layer) * 2 + d) * 16 + h)) * 8192 + e4 * 4) = v1 * __expf(TOT[s2]) + v2;
    }
}

__device__ __forceinline__ void phaseB3(const Args& a, unsigned char* lds, int layer) {
    const int tid = ltid(), lane = tid & 63, wave = tid >> 6, fr = lane & 15, fq = lane >> 4;
    const bf16_t* U = (const bf16_t*)(a.ws + WS_U); const float* DT = (const float*)(a.ws + WS_DT);
    const bf16_t* SINL = (const bf16_t*)(a.ws + WS_SINL); const bf16_t* SINC = (const bf16_t*)(a.ws + WS_SINC); float* SSQ = (float*)(a.ws + WS_SSQ); bf16_t* YS = (bf16_t*)(a.ws + WS_YS);
    for (int u = vblock(); u < 256; u += gridDim.x) {
        const SsdUnit su = ssd_unit(u);
        { const int i = wave >> 1, d = wave & 1, head = su.g * 8 + su.hh * 4 + i;
          (void)ssd_dtq(lds, wave, DT, su.row0, head, d, a.a_log + layer * 32, a.dt_bias + layer * 32, false); }
        ssd_load_conv<false, true>(lds, U, a.ssd_conv_w + (size_t)layer * 5 * 1536, a.ssd_conv_b + layer * 1536, su);
        __syncthreads();
        {
            bf16x8 Af[4];
#pragma unroll
            for (int ks = 0; ks < 4; ++ks) Af[ks] = *(const bf16x8*)(lds + BN_OFF + (16 * wave + fr) * XT_PITCH + (ks * 4 + fq) * 16);
            f32x4 cacc[8];
#pragma unroll
            for (int lt = 0; lt < 8; ++lt) { cacc[lt] = (f32x4){0.f, 0.f, 0.f, 0.f};
#pragma unroll
                for (int ks = 0; ks < 4; ++ks) { const bf16x8 Bf = *(const bf16x8*)(lds + CN_OFF + (lt * 16 + fr) * XT_PITCH + (ks * 4 + fq) * 16);
                    cacc[lt] = __builtin_amdgcn_mfma_f32_16x16x32_bf16(Af[ks], Bf, cacc[lt], 0, 0, 0); } }
            __syncthreads();
#pragma unroll
            for (int lt = 0; lt < 8; ++lt) { u32x2 o; o.x = cvt_pk_bf16(cacc[lt][0], cacc[lt][1]); o.y = cvt_pk_bf16(cacc[lt][2], cacc[lt][3]);
                *(u32x2*)(lds + BN_OFF + (lt * 16 + fr) * XT_PITCH + (16 * wave + 4 * fq) * 2) = o; }
            __syncthreads();
        }
        const int i = wave >> 1, lh = wave & 1, head = su.g * 8 + su.hh * 4 + i;
        f32x4 y[4][4];
#pragma unroll
        for (int pt = 0; pt < 4; ++pt)
#pragma unroll
            for (int lt = 0; lt < 4; ++lt) y[pt][lt] = (f32x4){0.f, 0.f, 0.f, 0.f};
#pragma unroll 1
        for (int d = 0; d < 2; ++d) {
            int frd = fr, fqd = fq; asm volatile("" : "+v"(frd), "+v"(fqd));

            const float* QA = (const float*)(lds + QA_OFF) + (i * 2 + d) * 128; const float* DTA = (const float*)(lds + DTA_OFF) + (i * 2 + d) * 128;
            const bf16_t* Sp = nullptr;
            if (su.ctx) { const int b = su.cu >> 1; if ((d == 0 && su.c == 1) || (d == 1 && su.c == 0)) Sp = SINC + (size_t)((b * 16 + head) * 2 + d) * 8192; }
            else Sp = SINL + (size_t)(((su.cu - 32) * 16 + head) * 2 + d) * 8192;
            u32x4 Sf[4][4];
            if (Sp) {
#pragma unroll
                for (int pt = 0; pt < 4; ++pt)
#pragma unroll
                    for (int ks = 0; ks < 2; ++ks) Sf[pt][ks] = *(const u32x4*)((const char*)Sp + (unsigned)(((pt * 16 + frd) * 128 + ks * 32 + fqd * 8) * 2));
            }
#pragma unroll
            for (int lt = 0; lt < 4; ++lt) { const int l0 = 64 * lh + lt * 16, l = l0 + frd; const float ql = QA[l];
#pragma unroll
                for (int ks = 0; ks < 4; ++ks) {
                    const bool skip = (d == 0) ? (32 * ks > l0 + 15) : (32 * ks + 31 < l0);
                    if (!skip) {
                        const int s0i = ks * 32 + fqd * 8;
                        const u32x4 cr = *(const u32x4*)(lds + BN_OFF + l * XT_PITCH + s0i * 2);
                        const f32x4 da = *(const f32x4*)(DTA + s0i), db = *(const f32x4*)(DTA + s0i + 4);
                        float cv[8] = {bf_lo(cr.x), bf_hi(cr.x), bf_lo(cr.y), bf_hi(cr.y), bf_lo(cr.z), bf_hi(cr.z), bf_lo(cr.w), bf_hi(cr.w)};
                        float gsv[8] = {da[0], da[1], da[2], da[3], db[0], db[1], db[2], db[3]};
                        float pv[8];
#pragma unroll
                        for (int j = 0; j < 8; ++j) { const int s = s0i + j; const bool ok = (d == 0) ? (s <= l) : (s >= l);
                            pv[j] = ok ? cv[j] * __builtin_amdgcn_exp2f(ql - gsv[j]) : 0.f; }
                        u32x4 o; o.x = cvt_pk_bf16(pv[0], pv[1]); o.y = cvt_pk_bf16(pv[2], pv[3]); o.z = cvt_pk_bf16(pv[4], pv[5]); o.w = cvt_pk_bf16(pv[6], pv[7]);
                        const bf16x8 Pf = as_bf16x8(o);
#pragma unroll
                        for (int pt = 0; pt < 4; ++pt) { const int R = i * 64 + pt * 16 + frd, chunk = ks * 4 + fqd;
                            const bf16x8 Af = *(const bf16x8*)(lds + XT_OFF + R * XT_PITCH + ((chunk ^ ((R >> 3) & 3)) * 16));
                            y[pt][lt] = __builtin_amdgcn_mfma_f32_16x16x32_bf16(Af, Pf, y[pt][lt], 0, 0, 0); }
                    }
                } }
            if (Sp) {
#pragma unroll
                for (int pt = 0; pt < 4; ++pt)
#pragma unroll
                    for (int ks = 2; ks < 4; ++ks) Sf[pt][ks] = *(const u32x4*)((const char*)Sp + (unsigned)(((pt * 16 + frd) * 128 + ks * 32 + fqd * 8) * 2));
                float eq[4];
#pragma unroll
                for (int lt = 0; lt < 4; ++lt) eq[lt] = __builtin_amdgcn_exp2f(QA[64 * lh + lt * 16 + frd]);
#pragma unroll
                for (int ks = 0; ks < 4; ++ks) {
                    bf16x8 Bf[4];
#pragma unroll
                    for (int lt = 0; lt < 4; ++lt) { const int l = 64 * lh + lt * 16 + frd; const float e1 = eq[lt];
                        const u32x4 cr = *(const u32x4*)(lds + CN_OFF + l * XT_PITCH + (ks * 4 + fqd) * 16);
                        u32x4 o; o.x = cvt_pk_bf16(bf_lo(cr.x) * e1, bf_hi(cr.x) * e1); o.y = cvt_pk_bf16(bf_lo(cr.y) * e1, bf_hi(cr.y) * e1);
                        o.z = cvt_pk_bf16(bf_lo(cr.z) * e1, bf_hi(cr.z) * e1); o.w = cvt_pk_bf16(bf_lo(cr.w) * e1, bf_hi(cr.w) * e1);
                        Bf[lt] = as_bf16x8(o); }
#pragma unroll
                    for (int pt = 0; pt < 4; ++pt)
#pragma unroll
                        for (int lt = 0; lt < 4; ++lt) y[pt][lt] = __builtin_amdgcn_mfma_f32_16x16x32_bf16(as_bf16x8(Sf[pt][ks]), Bf[lt], y[pt][lt], 0, 0, 0);
                }
            }
        }
        { const float Dh = a.ssd_d[layer * 16 + head];
#pragma unroll
          for (int pt = 0; pt < 4; ++pt)
#pragma unroll
            for (int lt = 0; lt < 4; ++lt) { const int l = 64 * lh + lt * 16 + fr;
#pragma unroll
                for (int r = 0; r < 4; ++r) { const int R = i * 64 + pt * 16 + 4 * fq + r;
                    const unsigned short xv = *(const unsigned short*)(lds + XT_OFF + R * XT_PITCH + (((l >> 3) ^ ((R >> 3) & 3)) * 16) + (l & 7) * 2);
                    y[pt][lt][r] += Dh * __uint_as_float((unsigned)xv << 16); } } }
        const int cgz = tid & 31, rsub = tid >> 5; const int zc = (su.g * 8 + su.hh * 4) * 64 + cgz * 8;
        u32x4 zr[8];
#pragma unroll
        for (int ps = 0; ps < 8; ++ps) zr[ps] = __builtin_nontemporal_load((const u32x4*)((const char*)U + uoff((unsigned)(su.row0 + ps * 16 + rsub), (unsigned)(U_Z + zc))));
        __syncthreads();
        { float* YL = (float*)lds;
#pragma unroll
          for (int pt = 0; pt < 4; ++pt)
#pragma unroll
            for (int lt = 0; lt < 4; ++lt) { const int l = 64 * lh + lt * 16 + fr; *(f32x4*)(YL + l * YL_PITCH + i * 64 + pt * 16 + 4 * fq) = y[pt][lt]; } }
        __syncthreads();
        { const float* YL = (const float*)lds;
#pragma unroll
          for (int ps = 0; ps < 8; ++ps) { const int l = ps * 16 + rsub; const unsigned row = (unsigned)(su.row0 + l);
              const f32x4 y0 = *(const f32x4*)(YL + l * YL_PITCH + cgz * 8), y1 = *(const f32x4*)(YL + l * YL_PITCH + cgz * 8 + 4);
              const u32x4 z4 = zr[ps];
              float v[8] = {y0[0] * bf_lo(z4.x), y0[1] * bf_hi(z4.x), y0[2] * bf_lo(z4.y), y0[3] * bf_hi(z4.y),
                            y1[0] * bf_lo(z4.z), y1[1] * bf_hi(z4.z), y1[2] * bf_lo(z4.w), y1[3] * bf_hi(z4.w)};
              float ss = 0.f;
#pragma unroll
              for (int j = 0; j < 8; ++j) ss += v[j] * v[j];
              u32x4 o; o.x = cvt_pk_bf16(v[0], v[1]); o.y = cvt_pk_bf16(v[2], v[3]); o.z = cvt_pk_bf16(v[4], v[5]); o.w = cvt_pk_bf16(v[6], v[7]);
              *(u32x4*)((char*)YS + (row * 2048u + (unsigned)(zc * 2))) = o;
#pragma unroll
              for (int m = 1; m < 32; m <<= 1) ss += __shfl_xor(ss, m);
              if (cgz == 0) SSQ[(size_t)row * 4 + su.g * 2 + su.hh] = ss; } }
        __syncthreads();
    }
}

__device__ __forceinline__ void phaseConf(const Args& a, unsigned char* lds, int layer) {
    const int tid = ltid();
    const bf16_t* U = (const bf16_t*)(a.ws + WS_U); bf16_t* YC = (bf16_t*)(a.ws + WS_YC);
    const int c0 = 2 * tid; const unsigned voff = (unsigned)(c0 * 2);
    f32x2 w[31];
#pragma unroll
    for (int k = 0; k < 31; ++k) w[k] = *(const f32x2*)((const char*)a.conf_conv_w + ((unsigned)((layer * 31 + k) * 4096) + 2u * voff));
    const f32x2 cb2 = *(const f32x2*)((const char*)a.conf_conv_b + ((unsigned)(layer * 4096) + 2u * voff));
    const f32x2 lg = *(const f32x2*)((const char*)a.conf_ln_g + ((unsigned)(layer * 4096) + 2u * voff)), lb = *(const f32x2*)((const char*)a.conf_ln_b + ((unsigned)(layer * 4096) + 2u * voff));
#pragma unroll 1
    for (int u = vblock(); u < 512; u += gridDim.x) {
        int rbase, rstride, pos0, plen;
        if (u < 256) { const int b = u >> 4; pos0 = (u & 15) * 16; plen = 256; rbase = b * 256; rstride = 1; }
        else { const int v = u - 256, b = v >> 7, wc = (v >> 1) & 63; pos0 = (v & 1) * 16; plen = 32; rbase = NCTXTOK + b * 2048 + wc; rstride = 64; }
        unsigned ra[46], gs[16];
#pragma unroll
        for (int i = 0; i < 46; ++i) { ra[i] = 0u; const int pos = pos0 + i - 15;
            if (pos >= 0 && pos < plen) ra[i] = *(const unsigned*)((const char*)U + uoff((unsigned)(rbase + pos * rstride), (unsigned)(U_GA + c0))); }
#pragma unroll
        for (int o = 0; o < 16; ++o) gs[o] = *(const unsigned*)((const char*)U + uoff((unsigned)(rbase + (pos0 + o) * rstride), (unsigned)(U_GS + c0)));
        f32x2 acc[16];
#pragma unroll
        for (int o = 0; o < 16; ++o) acc[o] = cb2;
#pragma unroll
        for (int i = 0; i < 46; ++i) { const f32x2 hh = (f32x2){bf_lo(ra[i]), bf_hi(ra[i])};
#pragma unroll
            for (int o = 0; o < 16; ++o) { const int k = i - o; if (k >= 0 && k < 31) acc[o] = __builtin_elementwise_fma(w[k], hh, acc[o]); } }
        float* red = (float*)lds;
#pragma unroll
        for (int o = 0; o < 16; ++o) { red[o * 512 + tid] = acc[o][0] + acc[o][1]; red[8192 + o * 512 + tid] = acc[o][0] * acc[o][0] + acc[o][1] * acc[o][1]; }
        __syncthreads();
        { const int o = tid >> 5, part = tid & 31; float s = 0.f, q = 0.f;
#pragma unroll
          for (int j = 0; j < 4; ++j) { const f32x4 t = *(const f32x4*)(red + o * 512 + part * 16 + j * 4), t2 = *(const f32x4*)(red + 8192 + o * 512 + part * 16 + j * 4);
              s += (t[0] + t[1]) + (t[2] + t[3]); q += (t2[0] + t2[1]) + (t2[2] + t2[3]); }
#pragma unroll
          for (int m = 1; m < 32; m <<= 1) { s += __shfl_xor(s, m); q += __shfl_xor(q, m); }
          __syncthreads();
          if (part == 0) { const float mean = s * (1.f / 1024.f); const float var = fmaxf(q * (1.f / 1024.f) - mean * mean, 0.f); red[2 * o] = mean; red[2 * o + 1] = rsqrtf(var + EPSF); } }
        __syncthreads();
#pragma unroll
        for (int o = 0; o < 16; ++o) { const unsigned row = (unsigned)(rbase + (pos0 + o) * rstride); const float mean = red[2 * o], rstd = red[2 * o + 1];
            const float v0 = silu_f((acc[o][0] - mean) * rstd * lg[0] + lb[0]) * bf_lo(gs[o]), v1 = silu_f((acc[o][1] - mean) * rstd * lg[1] + lb[1]) * bf_hi(gs[o]);
            *(unsigned*)((char*)YC + (row * 2048u + voff)) = cvt_pk_bf16(v0, v1); }
        __syncthreads();
    }
}

#define XB_TMO      128
#define XB_XCNT(j)  (256  + 64 * (j))
#define XB_XSUB(j)  (1280 + 64 * (j))
#define XB_XGEN(j)  (2304 + 64 * (j))
#define XB_TOP      3328
#define XB_TOPGEN   3392
#define XCD_BAR_WORDS 3456
#define XB_SPIN_CAP (1u << 18)
__device__ __forceinline__ unsigned xb_ld(unsigned* p)              { return __hip_atomic_load(p, __ATOMIC_RELAXED, __HIP_MEMORY_SCOPE_AGENT); }
__device__ __forceinline__ unsigned xb_add(unsigned* p, unsigned v) { return __hip_atomic_fetch_add(p, v, __ATOMIC_RELAXED, __HIP_MEMORY_SCOPE_AGENT); }
__device__ __forceinline__ unsigned xb_xcc_id() { return (unsigned)__builtin_amdgcn_s_getreg((3 << 11) | 20) & 0xFu; }
#define XB_SPIN(cond, bar) do { unsigned _sp = 0; while (cond) { __builtin_amdgcn_s_sleep(1); \
    if ((++_sp & 255u) == 0u) { if (xb_ld(&(bar)[XB_TMO])) break; if (_sp > XB_SPIN_CAP) { atomicAdd(&(bar)[XB_TMO], 1u); break; } } } } while (0)
struct XcdBarrier { unsigned* bar; unsigned x; volatile LAS unsigned* st; };
__device__ __forceinline__ XcdBarrier xcd_barrier_post(unsigned* bar, volatile LAS unsigned* st) {
    XcdBarrier b; b.bar = bar; b.x = xb_xcc_id(); b.st = st;
    if (threadIdx.x == 0) (void)xb_add(&bar[XB_XCNT(b.x)], 1u);
    return b;
}
__device__ __forceinline__ void xcd_barrier_complete(unsigned* bar, unsigned x, unsigned& nloc, unsigned& nx) {
    const unsigned G = gridDim.x * gridDim.y * gridDim.z;
    unsigned sum, cnt, mine, sp = 0u;
    for (;;) {
        sum = 0u; cnt = 0u; mine = 0u;
#pragma unroll
        for (unsigned j = 0; j < 16; ++j) { const unsigned c = xb_ld(&bar[XB_XCNT(j)]); sum += c; cnt += (c > 0u) ? 1u : 0u; mine = (j == x) ? c : mine; }
        if (sum == G) break;
        __builtin_amdgcn_s_sleep(1);
        if ((++sp & 255u) == 0u) { if (xb_ld(&bar[XB_TMO])) break; if (sp > XB_SPIN_CAP) { atomicAdd(&bar[XB_TMO], 1u); break; } }
    }
    nloc = mine > 0u ? mine : 1u; nx = cnt > 0u ? cnt : 1u;
}
__device__ __forceinline__ void xcd_barrier(const XcdBarrier& b) {
    asm volatile("s_waitcnt vmcnt(0)" ::: "memory");
    __syncthreads();
    if (threadIdx.x == 0) {
        unsigned* bar = b.bar;
        __builtin_amdgcn_s_waitcnt(0);
        unsigned nloc = b.st[0], nx = b.st[1];
        if (nloc == 0u) { xcd_barrier_complete(bar, b.x, nloc, nx); b.st[0] = nloc; b.st[1] = nx; }
        const unsigned old = xb_add(&bar[XB_XSUB(b.x)], 1u);
        const unsigned gen = old / nloc;
        if (old + 1u == (gen + 1u) * nloc) {
            __builtin_amdgcn_fence(__ATOMIC_RELEASE, "agent");
            asm volatile("s_waitcnt vmcnt(0)" ::: "memory");
            const unsigned og = xb_add(&bar[XB_TOP], 1u);
            const unsigned tg = og / nx;
            if (og + 1u == (tg + 1u) * nx) xb_add(&bar[XB_TOPGEN], 1u);
            else XB_SPIN(xb_ld(&bar[XB_TOPGEN]) == tg, bar);
            __builtin_amdgcn_fence(__ATOMIC_ACQUIRE, "agent");
            xb_add(&bar[XB_XGEN(b.x)], 1u);
            asm volatile("s_waitcnt vmcnt(0)" ::: "memory");
        } else {
            XB_SPIN(xb_ld(&bar[XB_XGEN(b.x)]) == gen, bar);
            __builtin_amdgcn_fence(__ATOMIC_ACQUIRE, "agent");
            asm volatile("s_waitcnt vmcnt(0)" ::: "memory");
        }
    }
    __syncthreads();
}
constexpr size_t WS_BAR = 768 * 1024;
constexpr int LDS_BARST = 151552;

typedef const __attribute__((address_space(4))) Args* ArgsP;
__device__ __forceinline__ const Args& fresh_args() { ArgsP p = (ArgsP)__builtin_amdgcn_kernarg_segment_ptr(); asm volatile("" : "+s"(p)); return *(const Args*)p; }
#define a (fresh_args())
#define GSYNC() do { for (int _r = 0; _r < REP_SYNC; ++_r) { XcdBarrier _b; _b.bar = (unsigned*)(a.ws + WS_BAR); _b.x = xb_xcc_id(); _b.st = (volatile LAS unsigned*)((LAS unsigned char*)lds + LDS_BARST); xcd_barrier(_b); } } while (0)
template <int layer>
__device__ __forceinline__ void layer_body(unsigned char* lds) {

#pragma unroll 1
        for (int rep = 0; rep < REP_GEMM; ++rep) {
            pg8::Gemm g{(const bf16_t*)(a.ws + WS_H), (const bf16_t*)(a.ws + WS_H), (const bf16_t*)(a.ws + WS_WIN + layer * WIN_BYTES), NTOK, NIN, 1024, 1 << 30};
            pg8::StaticOrder S; S.init(NTOK, NIN, (int)gridDim.x, (int)blockIdx.x);
            pg8::EpiIn E{(bf16_t*)(a.ws + WS_U), (float*)(a.ws + WS_DT)};
            pg8::gemm_phase<pg8::EpiIn, pg8::StaticOrder>((LAS unsigned char*)lds, g, S, E);
        }
        GSYNC();
#pragma unroll 1
        for (int rep = 0; rep < REP_SSD; ++rep) phaseB1(a, lds, layer);
#pragma unroll 1
        for (int rep = 0; rep < REP_MISC; ++rep) phaseConf(a, lds, layer);
        GSYNC();
        phaseScan(a, layer);
        GSYNC();
#pragma unroll 1
        for (int rep = 0; rep < REP_SSD; ++rep) phaseB3(a, lds, layer);
        GSYNC();
#pragma unroll 1
        for (int rep = 0; rep < REP_GEMM; ++rep) {
            pg8::Gemm g{(const bf16_t*)(a.ws + WS_YS), (const bf16_t*)(a.ws + WS_YC), (const bf16_t*)(a.ws + WS_WOUT + layer * WOUT_BYTES), NTOK, 2048, 1024, 4};
            pg8::StaticOrder S; S.init(NTOK, 2048, (int)gridDim.x, (int)blockIdx.x);
            pg8::EpiOut E{(bf16_t*)(a.ws + WS_OUT)};
            pg8::gemm_phase<pg8::EpiOut, pg8::StaticOrder>((LAS unsigned char*)lds, g, S, E);
        }
        GSYNC();
        phaseE(a, layer);
        if (layer == 0) GSYNC();
}
__global__ void __launch_bounds__(512, 2) fwd_megakernel(Args a_unused) {
    extern __shared__ __attribute__((aligned(16))) unsigned char lds[];
    cg::grid_group grid = cg::this_grid();
    if (a.ws == nullptr) grid.sync();
    if (threadIdx.x < 2) ((volatile LAS unsigned*)((LAS unsigned char*)lds + LDS_BARST))[threadIdx.x] = 0u;
    __syncthreads();
    (void)xcd_barrier_post((unsigned*)(a.ws + WS_BAR), (volatile LAS unsigned*)((LAS unsigned char*)lds + LDS_BARST));
    for (int rep = 0; rep < REP_MISC; ++rep) phase0(a, lds);
    GSYNC();
    for (int rep = 0; rep < REP_MISC; ++rep) phase1(a);
    GSYNC();
    layer_body<0>(lds);
    layer_body<1>(lds);
}
#undef a
extern "C" void kernel_launch(void* const* d_in, const int* in_sizes, int n_in, void* d_out, int out_size, void* d_ws, size_t ws_size, hipStream_t stream) {
    static int grid = 0;
    if (grid == 0) {
        int dev = 0, cus = 0, per_cu = 0;
        (void)hipGetDevice(&dev);
        (void)hipDeviceGetAttribute(&cus, hipDeviceAttributeMultiprocessorCount, dev);
        (void)hipFuncSetAttribute((const void*)fwd_megakernel, hipFuncAttributeMaxDynamicSharedMemorySize, LDS_BYTES);
        (void)hipOccupancyMaxActiveBlocksPerMultiprocessor(&per_cu, (const void*)fwd_megakernel, 512, LDS_BYTES);
        (void)hipGetLastError();
        if (per_cu < 1) fprintf(stderr, "kernel_launch: occupancy query reports %d blocks/CU\n", per_cu);
        grid = cus > 0 ? cus : 256;
    }
    Args a{};
    const float** f = (const float**)&a;
    for (int i = 0; i < 21; ++i) f[i] = (const float*)d_in[i];
    a.out = (float*)d_out; a.ws = (unsigned char*)d_ws;
    (void)hipMemsetAsync((unsigned char*)d_ws + WS_BAR, 0, XCD_BAR_WORDS * 4, stream);
    void* args[] = {&a};
    hipError_t e = hipLaunchCooperativeKernel((void*)fwd_megakernel, dim3(grid), dim3(512), args, LDS_BYTES, stream);
    if (e != hipSuccess) fprintf(stderr, "cooperative launch failed: %s (grid %d)\n", hipGetErrorString(e), grid);
}
```

```cpp
#include <hip/hip_runtime.h>
#include <hip/hip_cooperative_groups.h>
#include <cstdio>
namespace cg = cooperative_groups;
#ifndef REP_GEMM
#define REP_GEMM 1
#endif
#ifndef REP_SYNC
#define REP_SYNC 1
#endif
#ifndef REP_SSD
#define REP_SSD 1
#endif
#ifndef REP_MISC
#define REP_MISC 1
#endif

#define LAS __attribute__((address_space(3)))
typedef unsigned short bf16_t;
typedef short bf16x8 __attribute__((ext_vector_type(8)));
typedef float f32x4 __attribute__((ext_vector_type(4)));
typedef float f32x2 __attribute__((ext_vector_type(2)));
typedef unsigned u32x4 __attribute__((ext_vector_type(4)));
typedef unsigned u32x2 __attribute__((ext_vector_type(2)));

constexpr int DM = 1024, NTOK = 8192, NCTXTOK = 4096;
constexpr int UC = 5632;
constexpr int NIN = 5888;
constexpr int INCOLS = 5664;
constexpr int U_Z = 0, U_X = 1024, U_B = 2048, U_C = 2176, U_GA = 2560, U_GB = 3584, U_GS = 4608;
constexpr float EPSF = 1e-6f;
constexpr unsigned U_PSTRIDE = 8192u * 512u + 36864u;
__host__ __device__ __forceinline__ unsigned uoff(unsigned row, unsigned col) { return (col >> 8) * U_PSTRIDE + row * 512u + (col & 255u) * 2u; }
constexpr size_t MiB = 1u << 20;
constexpr size_t WS_MOD = 0, WS_TOT = 256 * 1024, WS_SSQ = 512 * 1024;
constexpr size_t WS_WIN = 1 * MiB, WIN_BYTES = (size_t)NIN * 1024 * 2;
constexpr size_t WS_WOUT = 24 * MiB, WOUT_BYTES = (size_t)2048 * 1024 * 2;
constexpr size_t WS_H = 32 * MiB, WS_U = 48 * MiB, WS_OUT = 48 * MiB, WS_DT = 250 * MiB, WS_YS = 137 * MiB, WS_YC = 153 * MiB, WS_ST = 169 * MiB;
constexpr size_t WS_SINL = 32 * MiB  , WS_SINC = 234 * MiB;
constexpr int LDS_BYTES = 155648;

struct Args {
    const float *x_prompt, *x_sample, *state_ssd, *c, *c_ctx, *w_mod, *b_mod, *g_pre, *g_post, *w_in, *ssd_conv_w, *ssd_conv_b, *a_log, *dt_bias, *ssd_d, *ssd_norm_g,
        *conf_conv_w, *conf_conv_b, *conf_ln_g, *conf_ln_b, *w_out;
    float* out; unsigned char* ws;
};

__device__ __forceinline__ int ltid() { int t = (int)threadIdx.x; asm volatile("" : "+v"(t)); return t; }
typedef __bf16 bf16x2v __attribute__((ext_vector_type(2)));
__device__ __forceinline__ unsigned cvt_pk_bf16(float lo, float hi) { const f32x2 v = {lo, hi}; const bf16x2v b = __builtin_convertvector(v, bf16x2v); return __builtin_bit_cast(unsigned, b); }
__device__ __forceinline__ float bf_lo(unsigned w) { return __uint_as_float(w << 16); }
__device__ __forceinline__ float bf_hi(unsigned w) { return __uint_as_float(w & 0xffff0000u); }
__device__ __forceinline__ float silu_f(float v) { return v * __builtin_amdgcn_rcpf(1.f + __expf(-v)); }
__device__ __forceinline__ float sigmoid_f(float v) { return __builtin_amdgcn_rcpf(1.f + __expf(-v)); }
__device__ __forceinline__ float softplus_f(float v) { return fmaxf(v, 0.f) + log1pf(__expf(-fabsf(v))); }
__device__ __forceinline__ float wave_sum(float v) {
#pragma unroll
    for (int o = 1; o < 64; o <<= 1) v += __shfl_xor(v, o);
    return v;
}

namespace pg8 {
constexpr int BM = 256, BK = 64, HALF = 128, HTB = HALF * BK * 2, STAGE_BYTES = 8 * HTB, NXCD = 8, WGM = 8;
__host__ __device__ __forceinline__ int lds_byte(int r, int c) { const int st = (r >> 4) * 2 + (c >> 5), rr = r & 15, cc = c & 31, ob = rr * 64 + cc * 2; return st * 1024 + (ob ^ (((ob >> 9) & 1) << 5)); }
__host__ __device__ __forceinline__ void stage_rc(int b, int& R, int& C) { const int st = b / 1024, sb = b % 1024, swz = sb ^ (((sb >> 9) & 1) << 5); R = (st >> 1) * 16 + swz / 64; C = (st & 1) * 32 + (swz % 64) / 2; }
__host__ __device__ __forceinline__ int perm32(int rho) { const int n = rho >> 4, i = rho & 15; return 8 * (i >> 2) + 4 * n + (i & 3); }
struct Unit { int pm, pn; };
struct Gemm { const bf16_t* A; const bf16_t* A2; const bf16_t* Bt; int M, N, K, split; };
struct StaticOrder {
    int nM, nN, nwg, G, c;
    __device__ void init(int M, int N, int G_, int c_) { nM = M / BM; nN = N / BM; nwg = nM * nN; G = G_; c = c_; }
    __device__ bool next(int i, Unit& u) const {
        const long L = (long)i * G + c; if (L >= nwg) return false;
        int wgid = (int)L; { const int q = nwg / NXCD, r = nwg % NXCD, xcd = wgid % NXCD, off = wgid / NXCD; wgid = (xcd < r ? xcd * (q + 1) : r * (q + 1) + (xcd - r) * q) + off; }
        const int nig = WGM * nN, gid = wgid / nig, fm = gid * WGM, gsz = (nM - fm) < WGM ? (nM - fm) : WGM;
        u.pm = fm + ((wgid % nig) % gsz); u.pn = (wgid % nig) / gsz; return true;
    }
};

struct EpiIn {
    static constexpr bool PERM = true;
    bf16_t* U; float* DT;
    __device__ __forceinline__ void operator()(const f32x4 (&acc)[2][2][4][2], const Unit& u, int wr, int wc, int fr, int fq) const {
        const int row0 = u.pm * BM + wr * 64 + fr;
        if (u.pn >= 10 && u.pn < 18) {
            const int col0 = U_GA + (u.pn - 10) * 128 + wc * 32 + 8 * fq;
#pragma unroll
            for (int ai = 0; ai < 2; ++ai)
#pragma unroll
                for (int m = 0; m < 4; ++m) { bf16_t* rowp = (bf16_t*)((char*)U + uoff((unsigned)(row0 + ai * HALF + m * 16), (unsigned)col0));
                    f32x4 v0, v1;
#pragma unroll
                    for (int e = 0; e < 4; ++e) { v0[e] = acc[ai][0][m][0][e] * sigmoid_f(acc[ai][1][m][0][e]); v1[e] = acc[ai][0][m][1][e] * sigmoid_f(acc[ai][1][m][1][e]); }
                    u32x4 w; w.x = cvt_pk_bf16(v0[0], v0[1]); w.y = cvt_pk_bf16(v0[2], v0[3]); w.z = cvt_pk_bf16(v1[0], v1[1]); w.w = cvt_pk_bf16(v1[2], v1[3]);
                    *(u32x4*)(rowp) = w; }
        } else if (u.pn < 22) {
            const bool act = (u.pn < 4) || (u.pn >= 18);
            const int col0 = (u.pn < 10 ? u.pn * BM : U_GS + (u.pn - 18) * BM) + wc * 32 + 8 * fq;
#pragma unroll
            for (int ai = 0; ai < 2; ++ai)
#pragma unroll
                for (int m = 0; m < 4; ++m) { bf16_t* rowp = (bf16_t*)((char*)U + uoff((unsigned)(row0 + ai * HALF + m * 16), (unsigned)col0));
#pragma unroll
                    for (int bj = 0; bj < 2; ++bj) { f32x4 v0 = acc[ai][bj][m][0], v1 = acc[ai][bj][m][1];
                        if (act) {
#pragma unroll
                            for (int e = 0; e < 4; ++e) { v0[e] = silu_f(v0[e]); v1[e] = silu_f(v1[e]); } }
                        u32x4 w; w.x = cvt_pk_bf16(v0[0], v0[1]); w.y = cvt_pk_bf16(v0[2], v0[3]); w.z = cvt_pk_bf16(v1[0], v1[1]); w.w = cvt_pk_bf16(v1[2], v1[3]);
                        *(u32x4*)(rowp + bj * HALF) = w; } }
        } else if (wc == 0) {
#pragma unroll
            for (int ai = 0; ai < 2; ++ai)
#pragma unroll
                for (int m = 0; m < 4; ++m) { float* rowp = DT + (size_t)(row0 + ai * HALF + m * 16) * 32 + 8 * fq;
                    *(f32x4*)(rowp) = acc[ai][0][m][0]; *(f32x4*)(rowp + 4) = acc[ai][0][m][1]; }
        }
    }
};
struct EpiOut {
    static constexpr bool PERM = true;
    bf16_t* O;
    __device__ __forceinline__ void operator()(const f32x4 (&acc)[2][2][4][2], const Unit& u, int wr, int wc, int fr, int fq) const {
        const int row0 = u.pm * BM + wr * 64 + fr, col0 = u.pn * BM + wc * 32 + 8 * fq;
#pragma unroll
        for (int ai = 0; ai < 2; ++ai)
#pragma unroll
            for (int m = 0; m < 4; ++m) { const int row = row0 + ai * HALF + m * 16;
                bf16_t* rowp = O + (size_t)row * 2048 + col0;
#pragma unroll
                for (int bj = 0; bj < 2; ++bj) { const f32x4 v0 = acc[ai][bj][m][0], v1 = acc[ai][bj][m][1];
                    u32x4 w; w.x = cvt_pk_bf16(v0[0], v0[1]); w.y = cvt_pk_bf16(v0[2], v0[3]); w.z = cvt_pk_bf16(v1[0], v1[1]); w.w = cvt_pk_bf16(v1[2], v1[3]);
                    *(u32x4*)(rowp + bj * HALF) = w; } }
    }
};

template <class Epi, class Sched>
__device__ __forceinline__ void gemm_phase(LAS unsigned char* lds, const Gemm g, const Sched& S, const Epi& E) {
    const int tid = ltid(), wid = __builtin_amdgcn_readfirstlane(tid >> 6), lane = tid & 63, wr = wid >> 2, wc = wid & 3, fr = lane & 15, fq = lane >> 4;
    const int K = g.K, nt = K / BK;
    unsigned voffA[2], voffB[2];
#pragma unroll
    for (int i = 0; i < 2; ++i) { int R, C; stage_rc(tid * 16 + i * 8192, R, C); const int Rb = Epi::PERM ? ((R & ~31) + perm32(R & 31)) : R;
        voffA[i] = (unsigned)(R * K + C) * 2u; voffB[i] = (unsigned)(Rb * K + C) * 2u; }
    const size_t kstep = (size_t)(BK * 2);
    const size_t hstep = (size_t)HALF * K * 2;
    const size_t tstep = 2 * hstep;
    const unsigned ldsw = (unsigned)wid * 1024u;
    const int aoff = lds_byte(wr * 64 + fr, fq * 8), boff = lds_byte(wc * 32 + fr, fq * 8);
#define PG8_SA(b, h) (((b) * 2 + (h)) * HTB)
#define PG8_SB(b, h) ((4 + (b) * 2 + (h)) * HTB)
#define PG8_STAGE(bufoff, gbase, voff) do { _Pragma("unroll") for (int _i = 0; _i < 2; ++_i) \
        __builtin_amdgcn_global_load_lds((const unsigned*)((const char*)(gbase) + (voff)[_i]), (LAS unsigned*)(lds + (bufoff) + ldsw + _i * 8192), 16, 0, 0); } while (0)
#define PG8_LDA(dst, b, h) do { _Pragma("unroll") for (int m = 0; m < 4; ++m) _Pragma("unroll") for (int k = 0; k < 2; ++k) dst[m][k] = *(const LAS bf16x8*)(lds + PG8_SA(b, h) + aoff + m * 2048 + k * 1024); } while (0)
#define PG8_LDB(dst, b, h) do { _Pragma("unroll") for (int n = 0; n < 2; ++n) _Pragma("unroll") for (int k = 0; k < 2; ++k) dst[n][k] = *(const LAS bf16x8*)(lds + PG8_SB(b, h) + boff + n * 2048 + k * 1024); } while (0)
#define PG8_MMA(ai, bj, At, Bt) do { __builtin_amdgcn_s_setprio(1); _Pragma("unroll") for (int m = 0; m < 4; ++m) _Pragma("unroll") for (int n = 0; n < 2; ++n) _Pragma("unroll") for (int k = 0; k < 2; ++k) \
        acc[ai][bj][m][n] = __builtin_amdgcn_mfma_f32_16x16x32_bf16(Bt[n][k], At[m][k], acc[ai][bj][m][n], 0, 0, 0); __builtin_amdgcn_s_setprio(0); } while (0)
#define PG8_WAIT_V(n) asm volatile("s_waitcnt vmcnt(" #n ")" ::: "memory")
#define PG8_WAIT_L(n) asm volatile("s_waitcnt lgkmcnt(" #n ")" ::: "memory")
#define PG8_BAR __builtin_amdgcn_s_barrier()
#define PG8_SCHED __builtin_amdgcn_sched_barrier(0)
    Unit cur, nxt; int ui = 0;
    if (!S.next(0, cur)) return;
    f32x4 acc[2][2][4][2];
#pragma unroll
    for (int a = 0; a < 2; ++a)
#pragma unroll
        for (int b = 0; b < 2; ++b)
#pragma unroll
            for (int m = 0; m < 4; ++m)
#pragma unroll
                for (int n = 0; n < 2; ++n) acc[a][b][m][n] = (f32x4){0.f, 0.f, 0.f, 0.f};
    bf16x8 At[4][2], B0[2][2], B1[2][2];
    const char* cA = (const char*)(cur.pn >= g.split ? g.A2 : g.A) + (size_t)cur.pm * tstep; const char* cB = (const char*)g.Bt + (size_t)cur.pn * tstep;
    PG8_STAGE(PG8_SB(0, 0), cB, voffB); PG8_STAGE(PG8_SA(0, 0), cA, voffA); PG8_STAGE(PG8_SB(0, 1), cB + hstep, voffB); PG8_STAGE(PG8_SA(0, 1), cA + hstep, voffA);
    if (wr == 1) PG8_BAR;
    PG8_WAIT_V(4); PG8_BAR;
    PG8_STAGE(PG8_SB(1, 0), cB + kstep, voffB); PG8_STAGE(PG8_SA(1, 0), cA + kstep, voffA); PG8_STAGE(PG8_SB(1, 1), cB + hstep + kstep, voffB);
    PG8_WAIT_V(6); PG8_BAR;
    for (;;) {
        const bool has_next = S.next(ui + 1, nxt);
        const char* nA = has_next ? (const char*)(nxt.pn >= g.split ? g.A2 : g.A) + (size_t)nxt.pm * tstep : cA; const char* nB = has_next ? (const char*)g.Bt + (size_t)nxt.pn * tstep : cB;
        for (int t = 0; t < nt; t += 2) {
            const bool last = (t == nt - 2);
            const char* a1 = cA + (size_t)(t + 1) * kstep;
            const char* a2 = last ? nA : cA + (size_t)(t + 2) * kstep; const char* b2 = last ? nB : cB + (size_t)(t + 2) * kstep;
            const char* a3 = a2 + kstep; const char* b3 = b2 + kstep;
            PG8_LDB(B0, 0, 0); PG8_SCHED; PG8_LDA(At, 0, 0); PG8_STAGE(PG8_SA(1, 1), a1 + hstep, voffA);
            PG8_WAIT_L(8); PG8_BAR; PG8_WAIT_L(0); PG8_MMA(0, 0, At, B0); PG8_BAR; PG8_SCHED;
            PG8_LDB(B1, 0, 1); PG8_STAGE(PG8_SB(0, 0), b2, voffB);
            PG8_BAR; PG8_WAIT_L(0); PG8_MMA(0, 1, At, B1); PG8_BAR;
            PG8_LDA(At, 0, 1); PG8_STAGE(PG8_SA(0, 0), a2, voffA);
            PG8_BAR; PG8_WAIT_L(0); PG8_MMA(1, 0, At, B0); PG8_BAR; PG8_SCHED;
            PG8_STAGE(PG8_SB(0, 1), b2 + hstep, voffB);
            PG8_WAIT_V(6); PG8_BAR; PG8_MMA(1, 1, At, B1); PG8_BAR;
            PG8_LDB(B0, 1, 0); PG8_SCHED; PG8_LDA(At, 1, 0); PG8_STAGE(PG8_SA(0, 1), a2 + hstep, voffA);
            PG8_WAIT_L(8); PG8_BAR; PG8_WAIT_L(0); PG8_MMA(0, 0, At, B0); PG8_BAR; PG8_SCHED;
            PG8_LDB(B1, 1, 1); PG8_STAGE(PG8_SB(1, 0), b3, voffB);
            PG8_BAR; PG8_WAIT_L(0); PG8_MMA(0, 1, At, B1); PG8_BAR;
            PG8_LDA(At, 1, 1); PG8_STAGE(PG8_SA(1, 0), a3, voffA);
            PG8_BAR; PG8_WAIT_L(0); PG8_MMA(1, 0, At, B0); PG8_BAR; PG8_SCHED;
            PG8_STAGE(PG8_SB(1, 1), b3 + hstep, voffB);
            PG8_WAIT_V(6); PG8_BAR; PG8_MMA(1, 1, At, B1); PG8_BAR;
        }
        E(acc, cur, wr, wc, fr, fq);
        if (!has_next) break;
#pragma unroll
        for (int a = 0; a < 2; ++a)
#pragma unroll
            for (int b = 0; b < 2; ++b)
#pragma unroll
                for (int m = 0; m < 4; ++m)
#pragma unroll
                    for (int n = 0; n < 2; ++n) acc[a][b][m][n] = (f32x4){0.f, 0.f, 0.f, 0.f};
        cur = nxt; cA = nA; cB = nB; ++ui;
    }
    PG8_WAIT_V(0);
    if (wr == 0) PG8_BAR;
    PG8_BAR;
#undef PG8_SA
#undef PG8_SB
#undef PG8_STAGE
#undef PG8_LDA
#undef PG8_LDB
#undef PG8_MMA
#undef PG8_WAIT_V
#undef PG8_WAIT_L
#undef PG8_BAR
#undef PG8_SCHED
}
}

__device__ __forceinline__ void p0_transpose_item(const float* W, int Nsrc, int nsrc, int k0src, bf16_t* WT, int Kdst, int ndst0, int k0dst, const float* kscale, float* scr, int lane) {
    float v[64];
    if (nsrc >= 0) {
#pragma unroll
        for (int kk = 0; kk < 64; ++kk) v[kk] = __builtin_nontemporal_load(W + (size_t)(k0src + kk) * Nsrc + nsrc);
    } else {
#pragma unroll
        for (int kk = 0; kk < 64; ++kk) v[kk] = 0.f;
    }
    if (kscale) { const float ks = kscale[k0dst + lane];
#pragma unroll
        for (int kk = 0; kk < 64; ++kk) v[kk] *= __shfl(ks, kk); }
#pragma unroll
    for (int kk = 0; kk < 64; ++kk) scr[kk * 65 + lane] = v[kk];
    asm volatile("s_waitcnt lgkmcnt(0)" ::: "memory");
    const int c = lane & 7;
#pragma unroll
    for (int j = 0; j < 8; ++j) { const int n = (lane >> 3) + 8 * j; const float* s = scr + (8 * c) * 65 + n;
        u32x4 o; o.x = cvt_pk_bf16(s[0 * 65], s[1 * 65]); o.y = cvt_pk_bf16(s[2 * 65], s[3 * 65]); o.z = cvt_pk_bf16(s[4 * 65], s[5 * 65]); o.w = cvt_pk_bf16(s[6 * 65], s[7 * 65]);
        *(u32x4*)(WT + (size_t)(ndst0 + n) * Kdst + k0dst + 8 * c) = o; }
    asm volatile("s_waitcnt lgkmcnt(0)" ::: "memory");
}

__device__ __forceinline__ void phase0(const Args& a, unsigned char* lds) {
    const int tid = ltid(), lane = tid & 63, wave = tid >> 6;
    for (int unit = blockIdx.x; unit < 96; unit += gridDim.x) {
        const int l = unit / 48, jb = unit % 48;
        float cv[3][2];
#pragma unroll
        for (int r = 0; r < 3; ++r) { const float* src = (r == 0) ? a.c_ctx : a.c + (r - 1) * 1024;
#pragma unroll
            for (int t = 0; t < 2; ++t) cv[r][t] = silu_f(src[128 * wave + 64 * t + lane]); }
        float acc0 = 0.f, acc1 = 0.f, acc2 = 0.f;
        const float* W = a.w_mod + (size_t)l * 1024 * 3072 + (size_t)(128 * wave) * 3072 + 64 * jb + lane;
#pragma unroll
        for (int t = 0; t < 2; ++t) {
#pragma unroll 32
            for (int kk = 0; kk < 64; ++kk) { const float wv = __builtin_nontemporal_load(W + (size_t)(64 * t + kk) * 3072);
                acc0 += __shfl(cv[0][t], kk) * wv; acc1 += __shfl(cv[1][t], kk) * wv; acc2 += __shfl(cv[2][t], kk) * wv; }
        }
        float* red = (float*)lds;
        red[(wave * 3 + 0) * 64 + lane] = acc0; red[(wave * 3 + 1) * 64 + lane] = acc1; red[(wave * 3 + 2) * 64 + lane] = acc2;
        __syncthreads();
        if (wave < 3) { float s = 0.f;
#pragma unroll
            for (int w = 0; w < 8; ++w) s += red[(w * 3 + wave) * 64 + lane];
            ((float*)(a.ws + WS_MOD))[(l * 3 + wave) * 3072 + 64 * jb + lane] = s + a.b_mod[l * 3072 + 64 * jb + lane]; }
        __syncthreads();
    }
    float* scr = (float*)(lds + 8192 + wave * 16640);
    const int gw = blockIdx.x * 8 + wave, NGW = gridDim.x * 8;
    constexpr int I_IN = 16 * (NIN / 64), I_OUT = 2 * 16 * 16, I_L = I_IN + I_OUT;
    for (int it = gw; it < 2 * I_L; it += NGW) {
        const int l = it / I_L; int r = it % I_L;
        if (r < I_IN) {
            const int kb = r / (NIN / 64), nb = r % (NIN / 64), n0 = nb * 64;
            int ns;
            if (n0 < 2048) ns = n0 + lane;
            else if (n0 < 2560) { const int gg = (n0 - 2048) >> 8, rr = (n0 - 2048) & 255; ns = ((rr < 128) ? 2048 + 128 * gg + rr : 2304 + 128 * gg + (rr - 128)) + lane; }
            else if (n0 < 4608) { const int t = (n0 - 2560) >> 8, rr = (n0 - 2560) & 255; ns = ((rr < 128) ? 2592 + 128 * t + rr : 3616 + 128 * t + (rr - 128)) + lane; }
            else if (n0 < 5632) ns = n0 + 32 + lane;
            else if (n0 == 5632) ns = (lane < 32) ? 2560 + lane : -1;
            else ns = -1;
            p0_transpose_item(a.w_in + (size_t)l * 1024 * INCOLS, INCOLS, ns, kb * 64, (bf16_t*)(a.ws + WS_WIN + l * WIN_BYTES), 1024, n0, kb * 64, nullptr, scr, lane);
        } else {
            r -= I_IN; const int half = r / 256; r %= 256; const int kb = r / 16, nb = r % 16;
            p0_transpose_item(a.w_out + (size_t)l * 2048 * 1024, 1024, nb * 64 + lane, half * 1024 + kb * 64, (bf16_t*)(a.ws + WS_WOUT + l * WOUT_BYTES), 1024, half * 1024 + nb * 64, kb * 64,
                              half == 0 ? a.ssd_norm_g + l * 1024 : nullptr, scr, lane);
        }
    }
}

__device__ __forceinline__ void normmod_row(const f32x4 (&v)[4], const Args& a, int layer, int rg, bf16_t* hrow, int lane) {
    float s = 0.f;
#pragma unroll
    for (int j = 0; j < 4; ++j) s += (v[j][0] * v[j][0] + v[j][1] * v[j][1]) + (v[j][2] * v[j][2] + v[j][3] * v[j][3]);
    const float r = rsqrtf(wave_sum(s) * (1.f / 1024.f) + EPSF);
    const float* mod = (const float*)(a.ws + WS_MOD) + (size_t)(layer * 3 + rg) * 3072;
#pragma unroll
    for (int j = 0; j < 4; ++j) { const int c0 = 4 * lane + 256 * j;
        const f32x4 g = *(const f32x4*)(a.g_pre + layer * 1024 + c0), sh = *(const f32x4*)(mod + c0), sc = *(const f32x4*)(mod + 1024 + c0);
        f32x4 h;
#pragma unroll
        for (int e = 0; e < 4; ++e) h[e] = v[j][e] * r * g[e] * (1.f + sc[e]) + sh[e];
        u32x2 o; o.x = cvt_pk_bf16(h[0], h[1]); o.y = cvt_pk_bf16(h[2], h[3]);
        *(u32x2*)(hrow + c0) = o; }
}
__device__ __forceinline__ void normmod_row_pre(const f32x4 (&v)[4], const f32x4 (&g)[4], const f32x4 (&sh)[4], const f32x4 (&sc)[4], bf16_t* hrow, int lane) {
    float s = 0.f;
#pragma unroll
    for (int j = 0; j < 4; ++j) s += (v[j][0] * v[j][0] + v[j][1] * v[j][1]) + (v[j][2] * v[j][2] + v[j][3] * v[j][3]);
    const float r = rsqrtf(wave_sum(s) * (1.f / 1024.f) + EPSF);
#pragma unroll
    for (int j = 0; j < 4; ++j) { const int c0 = 4 * lane + 256 * j;
        f32x4 h;
#pragma unroll
        for (int e = 0; e < 4; ++e) h[e] = v[j][e] * r * g[j][e] * (1.f + sc[j][e]) + sh[j][e];
        u32x2 o; o.x = cvt_pk_bf16(h[0], h[1]); o.y = cvt_pk_bf16(h[2], h[3]);
        *(u32x2*)(hrow + c0) = o; }
}
__device__ __forceinline__ int row_group(int row) { return row < NCTXTOK ? 0 : 1 + ((row - NCTXTOK) >> 11); }

__device__ __forceinline__ void phase1(const Args& a) {
    const int lane = ltid() & 63, gw = blockIdx.x * 8 + (ltid() >> 6), NGW = gridDim.x * 8;
    for (int row0 = 2 * gw; row0 < NTOK; row0 += 2 * NGW) {
        f32x4 v[2][4];
        const float* m0 = (const float*)(a.ws + WS_MOD) + (size_t)row_group(row0) * 3072;
        f32x4 g0v[4], sh0v[4], sc0v[4];
#pragma unroll
        for (int j = 0; j < 4; ++j) { const int c0 = 4 * lane + 256 * j; g0v[j] = *(const f32x4*)(a.g_pre + c0); sh0v[j] = *(const f32x4*)(m0 + c0); sc0v[j] = *(const f32x4*)(m0 + 1024 + c0); }
#pragma unroll
        for (int t = 0; t < 2; ++t) { const int row = row0 + t;
            if (row < NTOK) { const float* xr = (row < NCTXTOK) ? a.x_prompt + (size_t)row * 1024 : a.x_sample + (size_t)(row - NCTXTOK) * 1024;
#pragma unroll
                for (int j = 0; j < 4; ++j) v[t][j] = *(const f32x4*)(xr + 4 * lane + 256 * j); } }
#pragma unroll
        for (int t = 0; t < 2; ++t) { const int row = row0 + t;
            if (row < NTOK) normmod_row_pre(v[t], g0v, sh0v, sc0v, (bf16_t*)(a.ws + WS_H) + (size_t)row * 1024, lane); }
    }
}

__device__ __forceinline__ void phaseE(const Args& a, int layer) {
    const int lane = ltid() & 63, gw = blockIdx.x * 8 + (ltid() >> 6), NGW = gridDim.x * 8;
    const bf16_t* O = (const bf16_t*)(a.ws + WS_OUT);
    for (int row0 = 2 * gw; row0 < NTOK; row0 += 2 * NGW) {
        u32x2 pb[2][4], qb[2][4]; f32x4 xv[2][4]; int rows[2]; bool have[2]; float sqv[2];
        const int rgp = row_group(row0);
        const float* modp = (const float*)(a.ws + WS_MOD) + (size_t)(layer * 3 + rgp) * 3072;
        f32x4 gpv[4], gtv[4], g1v[4], sh1v[4], sc1v[4];
#pragma unroll
        for (int j = 0; j < 4; ++j) { const int c0 = 4 * lane + 256 * j; gpv[j] = *(const f32x4*)(a.g_post + layer * 1024 + c0); gtv[j] = *(const f32x4*)(modp + 2048 + c0);
            if (layer == 0) { const float* m1 = (const float*)(a.ws + WS_MOD) + (size_t)(3 + rgp) * 3072; g1v[j] = *(const f32x4*)(a.g_pre + 1024 + c0); sh1v[j] = *(const f32x4*)(m1 + c0); sc1v[j] = *(const f32x4*)(m1 + 1024 + c0); } }
#pragma unroll
        for (int t = 0; t < 2; ++t) { const int row = row0 + t; rows[t] = row; have[t] = row < NTOK; sqv[t] = 0.f;
            if (have[t]) {
                sqv[t] = ((const float*)(a.ws + WS_SSQ))[(size_t)row * 4 + (lane & 3)];
                const float* xr = (layer == 0) ? ((row < NCTXTOK) ? a.x_prompt + (size_t)row * 1024 : a.x_sample + (size_t)(row - NCTXTOK) * 1024) : a.out + (size_t)row * 1024;
#pragma unroll
                for (int j = 0; j < 4; ++j) { const int c0 = 4 * lane + 256 * j; pb[t][j] = __builtin_nontemporal_load((const u32x2*)(O + (size_t)row * 2048 + c0)); qb[t][j] = __builtin_nontemporal_load((const u32x2*)(O + (size_t)row * 2048 + 1024 + c0)); xv[t][j] = __builtin_nontemporal_load((const f32x4*)(xr + c0)); } } }
        f32x4 o[2][4]; float ssum[2], ssum2[2];
#pragma unroll
        for (int t = 0; t < 2; ++t) {
            float sq = sqv[t]; sq += __shfl_xor(sq, 1); sq += __shfl_xor(sq, 2);
            const float rsn = rsqrtf(sq * (1.f / 1024.f) + EPSF);
            float s = 0.f;
#pragma unroll
            for (int j = 0; j < 4; ++j) { const u32x2 p2 = pb[t][j], q2 = qb[t][j];
                o[t][j] = (f32x4){rsn * bf_lo(p2.x) + bf_lo(q2.x), rsn * bf_hi(p2.x) + bf_hi(q2.x), rsn * bf_lo(p2.y) + bf_lo(q2.y), rsn * bf_hi(p2.y) + bf_hi(q2.y)};
                s += (o[t][j][0] * o[t][j][0] + o[t][j][1] * o[t][j][1]) + (o[t][j][2] * o[t][j][2] + o[t][j][3] * o[t][j][3]); }
            ssum[t] = s; }
#pragma unroll
        for (int sh = 1; sh < 64; sh <<= 1) { const float t0 = __shfl_xor(ssum[0], sh), t1 = __shfl_xor(ssum[1], sh); ssum[0] += t0; ssum[1] += t1; }
#pragma unroll
        for (int t = 0; t < 2; ++t) { const float r = rsqrtf(ssum[t] * (1.f / 1024.f) + EPSF); float s2 = 0.f;
#pragma unroll
            for (int j = 0; j < 4; ++j) { const f32x4 gp = gpv[j], gt = gtv[j];
#pragma unroll
                for (int e = 0; e < 4; ++e) xv[t][j][e] = xv[t][j][e] + gt[e] * (o[t][j][e] * r * gp[e]);
                s2 += (xv[t][j][0] * xv[t][j][0] + xv[t][j][1] * xv[t][j][1]) + (xv[t][j][2] * xv[t][j][2] + xv[t][j][3] * xv[t][j][3]);
                if (have[t]) __builtin_nontemporal_store(xv[t][j], (f32x4*)(a.out + (size_t)rows[t] * 1024 + 4 * lane + 256 * j)); }
            ssum2[t] = s2; }
        if (layer == 0) {
#pragma unroll
            for (int sh = 1; sh < 64; sh <<= 1) { const float t0 = __shfl_xor(ssum2[0], sh), t1 = __shfl_xor(ssum2[1], sh); ssum2[0] += t0; ssum2[1] += t1; }
#pragma unroll
            for (int t = 0; t < 2; ++t) if (have[t]) { const float r1 = rsqrtf(ssum2[t] * (1.f / 1024.f) + EPSF); bf16_t* hrow = (bf16_t*)(a.ws + WS_H) + (size_t)rows[t] * 1024;
#pragma unroll
                for (int j = 0; j < 4; ++j) { const int c0 = 4 * lane + 256 * j; f32x4 h;
#pragma unroll
                    for (int e = 0; e < 4; ++e) h[e] = xv[t][j][e] * r1 * g1v[j][e] * (1.f + sc1v[j][e]) + sh1v[j][e];
                    u32x2 ob; ob.x = cvt_pk_bf16(h[0], h[1]); ob.y = cvt_pk_bf16(h[2], h[3]);
                    *(u32x2*)(hrow + c0) = ob; } }
        }
    }
}

__device__ __forceinline__ int vblock() { const int G = gridDim.x, bx = blockIdx.x; return (G % 8 == 0) ? (bx % 8) * (G / 8) + bx / 8 : bx; }
constexpr int XT_OFF = 0, XT_PITCH = 272, CN_OFF = 69632, BN_OFF = 104448, QA_OFF = 139264, DTA_OFF = 143360, SCA_OFF = 147456;
constexpr int YL_PITCH = 260;

struct SsdUnit { int cu, g, hh, row0, tl0, L; bool ctx; int c; };
__device__ __forceinline__ SsdUnit ssd_unit(int u) {
    SsdUnit s; s.cu = u >> 2; s.g = (u >> 1) & 1; s.hh = u & 1;
    if (s.cu < 32) { s.ctx = true; const int b = s.cu >> 1; s.c = s.cu & 1; s.L = 256; s.row0 = b * 256 + s.c * 128; }
    else { s.ctx = false; const int v = s.cu - 32, b = v >> 4; s.c = v & 15; s.L = 2048; s.row0 = NCTXTOK + b * 2048 + s.c * 128; }
    s.tl0 = s.c * 128; return s;
}

__device__ __forceinline__ f32x2 silu2(f32x2 v) {
    const f32x2 t = v * (-1.44269504f);
    f32x2 e; e[0] = __builtin_amdgcn_exp2f(t[0]); e[1] = __builtin_amdgcn_exp2f(t[1]);
    const f32x2 d = e + 1.0f;
    f32x2 r; r[0] = __builtin_amdgcn_rcpf(d[0]); r[1] = __builtin_amdgcn_rcpf(d[1]);
    return v * r;
}
template <bool BTR, bool NEEDC>
__device__ __forceinline__ void ssd_load_conv(unsigned char* lds, const bf16_t* U, const float* cw, const float* cbias, const SsdUnit& su) {
    const int tid = ltid(), lane = tid & 63, wave = tid >> 6, seg = wave >> 1;
    const int cgi = (wave & 1) * 64 + lane;
    int kind, ucol, cg4;
    if (cgi < 64) { kind = 0; cg4 = cgi; ucol = U_X + (su.g * 8 + su.hh * 4) * 64 + cg4 * 4; }
    else if (cgi < 96) { kind = 1; cg4 = cgi - 64; ucol = U_B + su.g * 256 + cg4 * 4; }
    else { kind = 2; cg4 = cgi - 96; ucol = U_C + su.g * 256 + cg4 * 4; }
    if (!NEEDC && kind == 2) return;
    const int ch = (kind == 0) ? ucol - 1024 : (kind == 1 ? 1024 + su.g * 128 + cg4 * 4 : 1280 + su.g * 128 + cg4 * 4);
    f32x2 w[5][2], bia[2];
#pragma unroll
    for (int k = 0; k < 5; ++k) { const f32x4 w0 = *(const f32x4*)(cw + k * 1536 + ch); w[k][0] = (f32x2){w0[0], w0[1]}; w[k][1] = (f32x2){w0[2], w0[3]}; }
    { const f32x4 b0 = *(const f32x4*)(cbias + ch); bia[0] = (f32x2){b0[0], b0[1]}; bia[1] = (f32x2){b0[2], b0[3]}; }
    const bool transposed = (kind == 0) || (BTR && kind == 1);
    const int seq_row0 = su.row0 - su.tl0;
    u32x2 rawall[36];
#pragma unroll
    for (int i = 0; i < 36; ++i) { int tl = su.tl0 + seg * 32 - 2 + i;
        if (i < 2) tl = tl < 0 ? 0 : tl;
        if (i >= 34) tl = tl >= su.L ? su.L - 1 : tl;
        rawall[i] = *(const u32x2*)((const char*)U + uoff((unsigned)(seq_row0 + tl), (unsigned)ucol)); }
    { const unsigned mlo = (su.tl0 + seg * 32 - 2 < 0) ? 0u : 0xffffffffu, mhi = (su.tl0 + seg * 32 + 34 > su.L) ? 0u : 0xffffffffu;
      rawall[0].x &= mlo; rawall[0].y &= mlo; rawall[1].x &= mlo; rawall[1].y &= mlo;
      rawall[34].x &= mhi; rawall[34].y &= mhi; rawall[35].x &= mhi; rawall[35].y &= mhi; }
#pragma unroll
    for (int sub = 0; sub < 4; ++sub) {
        const int rr = seg * 32 + sub * 8;
        f32x2 o[8][2];
#pragma unroll
        for (int r = 0; r < 8; ++r) { o[r][0] = bia[0]; o[r][1] = bia[1]; }
#pragma unroll
        for (int i = 0; i < 12; ++i) { const u32x2 rw = rawall[sub * 8 + i];
            const f32x2 v0 = (f32x2){bf_lo(rw.x), bf_hi(rw.x)}, v1 = (f32x2){bf_lo(rw.y), bf_hi(rw.y)};
#pragma unroll
            for (int k = 0; k < 5; ++k) { const int r = i - k; if (r >= 0 && r < 8) { o[r][0] = __builtin_elementwise_fma(w[k][0], v0, o[r][0]); o[r][1] = __builtin_elementwise_fma(w[k][1], v1, o[r][1]); } } }
#pragma unroll
        for (int r = 0; r < 8; ++r) { o[r][0] = silu2(o[r][0]); o[r][1] = silu2(o[r][1]); }
        if (transposed) {
            unsigned char* base = lds + (kind == 0 ? XT_OFF : CN_OFF);
            const int chunk = rr >> 3;
#pragma unroll
            for (int e = 0; e < 4; ++e) { const int R = cg4 * 4 + e; const int phys = chunk ^ ((R >> 3) & 3);
                u32x4 pk; pk.x = cvt_pk_bf16(o[0][e >> 1][e & 1], o[1][e >> 1][e & 1]); pk.y = cvt_pk_bf16(o[2][e >> 1][e & 1], o[3][e >> 1][e & 1]);
                pk.z = cvt_pk_bf16(o[4][e >> 1][e & 1], o[5][e >> 1][e & 1]); pk.w = cvt_pk_bf16(o[6][e >> 1][e & 1], o[7][e >> 1][e & 1]);
                *(u32x4*)(base + R * XT_PITCH + phys * 16) = pk; }
        } else {
            unsigned char* base = lds + (kind == 1 ? BN_OFF : CN_OFF);
#pragma unroll
            for (int r = 0; r < 8; ++r) { u32x2 pk; pk.x = cvt_pk_bf16(o[r][0][0], o[r][0][1]); pk.y = cvt_pk_bf16(o[r][1][0], o[r][1][1]);
                *(u32x2*)(base + (rr + r) * XT_PITCH + cg4 * 8) = pk; }
        }
    }
}

__device__ __forceinline__ float ssd_dtq(unsigned char* lds, int slot, const float* DT, int row0, int head, int d, const float* a_log_l, const float* dt_bias_l, bool want_sc) {
    const int lane = ltid() & 63;
    const float bias = dt_bias_l[d * 16 + head], av = -__expf(a_log_l[d * 16 + head]);
    const float r0 = DT[(size_t)(row0 + 2 * lane) * 32 + d * 16 + head], r1 = DT[(size_t)(row0 + 2 * lane + 1) * 32 + d * 16 + head];
    const float dt0 = softplus_f(r0 + bias), dt1 = softplus_f(r1 + bias);
    const float la0 = dt0 * av, la1 = dt1 * av, s = la0 + la1;
    float incl = s;
#pragma unroll
    for (int o = 1; o < 64; o <<= 1) { const float t = __shfl_up(incl, o); if (lane >= o) incl += t; }
    const float tot = __shfl(incl, 63), excl = incl - s;
    float q0, q1;
    if (d == 0) { q0 = excl + la0; q1 = incl; } else { q0 = tot - excl; q1 = tot - excl - la0; }
    float* QA = (float*)(lds + QA_OFF) + slot * 128; float* DTA = (float*)(lds + DTA_OFF) + slot * 128;
    *(f32x2*)(QA + 2 * lane) = (f32x2){q0 * 1.44269504f, q1 * 1.44269504f}; *(f32x2*)(DTA + 2 * lane) = (f32x2){q0 * 1.44269504f - __log2f(dt0), q1 * 1.44269504f - __log2f(dt1)};
    if (want_sc) { float* SCA = (float*)(lds + SCA_OFF) + slot * 128; *(f32x2*)(SCA + 2 * lane) = (f32x2){dt0 * __expf(tot - q0), dt1 * __expf(tot - q1)}; }
    return tot;
}

__device__ __forceinline__ bf16x8 as_bf16x8(u32x4 v) { return __builtin_bit_cast(bf16x8, v); }

__device__ __forceinline__ void phaseB1(const Args& a, unsigned char* lds, int layer) {
    const int tid = ltid(), lane = tid & 63, wave = tid >> 6, fr = lane & 15, fq = lane >> 4;
    const bf16_t* U = (const bf16_t*)(a.ws + WS_U); const float* DT = (const float*)(a.ws + WS_DT);
    float* ST = (float*)(a.ws + WS_ST); float* TOT = (float*)(a.ws + WS_TOT);
    for (int u = vblock(); u < 256; u += gridDim.x) {
        const SsdUnit su = ssd_unit(u);
        const int i = wave >> 1, d = wave & 1, head = su.g * 8 + su.hh * 4 + i;
        const float tot = ssd_dtq(lds, wave, DT, su.row0, head, d, a.a_log + layer * 32, a.dt_bias + layer * 32, true);
        const size_t sidx = (size_t)((su.cu * 16 + head) * 2 + d);
        if (lane == 0) TOT[sidx] = tot;
        ssd_load_conv<true, false>(lds, U, a.ssd_conv_w + (size_t)layer * 5 * 1536, a.ssd_conv_b + layer * 1536, su);
        __syncthreads();
        const float* SCA = (const float*)(lds + SCA_OFF) + wave * 128;
        bf16x8 Af[4][4];
#pragma unroll
        for (int pt = 0; pt < 4; ++pt)
#pragma unroll
            for (int ks = 0; ks < 4; ++ks) { const int R = i * 64 + pt * 16 + fr, chunk = ks * 4 + fq;
                const u32x4 xr = *(const u32x4*)(lds + XT_OFF + R * XT_PITCH + ((chunk ^ ((R >> 3) & 3)) * 16));
                const f32x4 s0 = *(const f32x4*)(SCA + chunk * 8), s1 = *(const f32x4*)(SCA + chunk * 8 + 4);
                u32x4 o; o.x = cvt_pk_bf16(bf_lo(xr.x) * s0[0], bf_hi(xr.x) * s0[1]); o.y = cvt_pk_bf16(bf_lo(xr.y) * s0[2], bf_hi(xr.y) * s0[3]);
                o.z = cvt_pk_bf16(bf_lo(xr.z) * s1[0], bf_hi(xr.z) * s1[1]); o.w = cvt_pk_bf16(bf_lo(xr.w) * s1[2], bf_hi(xr.w) * s1[3]);
                Af[pt][ks] = as_bf16x8(o); }
        float* stp = ST + sidx * 8192;
#pragma unroll 1
        for (int nt = 0; nt < 8; ++nt) {
            f32x4 acc[4];
#pragma unroll
            for (int pt = 0; pt < 4; ++pt) acc[pt] = (f32x4){0.f, 0.f, 0.f, 0.f};
#pragma unroll
            for (int ks = 0; ks < 4; ++ks) { const int n = nt * 16 + fr, chunk = ks * 4 + fq;
                const bf16x8 Bf = *(const bf16x8*)(lds + CN_OFF + n * XT_PITCH + ((chunk ^ ((n >> 3) & 3)) * 16));
#pragma unroll
                for (int pt = 0; pt < 4; ++pt) acc[pt] = __builtin_amdgcn_mfma_f32_16x16x32_bf16(Bf, Af[pt][ks], acc[pt], 0, 0, 0); }
#pragma unroll
            for (int pt = 0; pt < 4; ++pt) {
                if (su.ctx) *(f32x4*)(stp + (pt * 16 + fr) * 128 + nt * 16 + 4 * fq) = acc[pt];
                else { u32x2 o; o.x = cvt_pk_bf16(acc[pt][0], acc[pt][1]); o.y = cvt_pk_bf16(acc[pt][2], acc[pt][3]); *(u32x2*)((bf16_t*)stp + (pt * 16 + fr) * 128 + nt * 16 + 4 * fq) = o; } }
        }
        __syncthreads();
    }
}

__device__ __forceinline__ void phaseScan(const Args& a, int layer) {
    const float* ST = (const float*)(a.ws + WS_ST); const float* TOT = (const float*)(a.ws + WS_TOT);
    bf16_t* SINL = (bf16_t*)(a.ws + WS_SINL); bf16_t* SINC = (bf16_t*)(a.ws + WS_SINC);
    const int gid = blockIdx.x * 512 + ltid(), GT = gridDim.x * 512;
    for (int id = gid; id < 64 * 2048; id += GT) {
        const int chain = id >> 11, e4 = id & 2047, b = chain >> 5, h = (chain >> 1) & 15, d = chain & 1;
        f32x4 S = *(const f32x4*)(a.state_ssd + ((size_t)(((b * 2 + layer) * 2 + d) * 16 + h)) * 8192 + e4 * 4);
        f32x4 t[16]; float dec[16];
#pragma unroll
        for (int s = 0; s < 16; ++s) { const int c = d ? 15 - s : s; const size_t sidx = (size_t)(((32 + b * 16 + c) * 16 + h) * 2 + d);
            const u32x2 tb = __builtin_nontemporal_load((const u32x2*)((const bf16_t*)(ST + sidx * 8192) + e4 * 4)); t[s] = (f32x4){bf_lo(tb.x), bf_hi(tb.x), bf_lo(tb.y), bf_hi(tb.y)}; dec[s] = __expf(TOT[sidx]); }
#pragma unroll
        for (int s = 0; s < 16; ++s) { const int c = d ? 15 - s : s; const size_t lidx = (size_t)(((b * 16 + c) * 16 + h) * 2 + d);
            u32x2 o; o.x = cvt_pk_bf16(S[0], S[1]); o.y = cvt_pk_bf16(S[2], S[3]);
            *(u32x2*)(SINL + lidx * 8192 + e4 * 4) = o; S = S * dec[s] + t[s]; }
    }
    float* ns = a.out + (size_t)NTOK * 1024;
    for (int id = gid; id < 512 * 2048; id += GT) {
        const int chain = id >> 11, e4 = id & 2047, b = chain >> 5, h = (chain >> 1) & 15, d = chain & 1;
        const int c1 = d ? 1 : 0, c2 = d ? 0 : 1;
        const size_t s1 = (size_t)(((b * 2 + c1) * 16 + h) * 2 + d), s2 = (size_t)(((b * 2 + c2) * 16 + h) * 2 + d);
        const f32x4 v1 = __builtin_nontemporal_load((const f32x4*)(ST + s1 * 8192 + e4 * 4)), v2 = __builtin_nontemporal_load((const f32x4*)(ST + s2 * 8192 + e4 * 4));
        u32x2 o; o.x = cvt_pk_bf16(v1[0], v1[1]); o.y = cvt_pk_bf16(v1[2], v1[3]);
        *(u32x2*)(SINC + (size_t)chain * 8192 + e4 * 4) = o;
        *(f32x4*)(ns + ((size_t)(((b * 2 + layer) * 2 + d) * 16 + h)) * 8192 + e4 * 4) = v1 * __expf(TOT[s2]) + v2;
    }
}

__device__ __forceinline__ void phaseB3(const Args& a, unsigned char* lds, int layer) {
    const int tid = ltid(), lane = tid & 63, wave = tid >> 6, fr = lane & 15, fq = lane >> 4;
    const bf16_t* U = (const bf16_t*)(a.ws + WS_U); const float* DT = (const float*)(a.ws + WS_DT);
    const bf16_t* SINL = (const bf16_t*)(a.ws + WS_SINL); const bf16_t* SINC = (const bf16_t*)(a.ws + WS_SINC); float* SSQ = (float*)(a.ws + WS_SSQ); bf16_t* YS = (bf16_t*)(a.ws + WS_YS);
    for (int u = vblock(); u < 256; u += gridDim.x) {
        const SsdUnit su = ssd_unit(u);
        { const int i = wave >> 1, d = wave & 1, head = su.g * 8 + su.hh * 4 + i;
          (void)ssd_dtq(lds, wave, DT, su.row0, head, d, a.a_log + layer * 32, a.dt_bias + layer * 32, false); }
        ssd_load_conv<false, true>(lds, U, a.ssd_conv_w + (size_t)layer * 5 * 1536, a.ssd_conv_b + layer * 1536, su);
        __syncthreads();
        {
            bf16x8 Af[4];
#pragma unroll
            for (int ks = 0; ks < 4; ++ks) Af[ks] = *(const bf16x8*)(lds + BN_OFF + (16 * wave + fr) * XT_PITCH + (ks * 4 + fq) * 16);
            f32x4 cacc[8];
#pragma unroll
            for (int lt = 0; lt < 8; ++lt) { cacc[lt] = (f32x4){0.f, 0.f, 0.f, 0.f};
#pragma unroll
                for (int ks = 0; ks < 4; ++ks) { const bf16x8 Bf = *(const bf16x8*)(lds + CN_OFF + (lt * 16 + fr) * XT_PITCH + (ks * 4 + fq) * 16);
                    cacc[lt] = __builtin_amdgcn_mfma_f32_16x16x32_bf16(Af[ks], Bf, cacc[lt], 0, 0, 0); } }
            __syncthreads();
#pragma unroll
            for (int lt = 0; lt < 8; ++lt) { u32x2 o; o.x = cvt_pk_bf16(cacc[lt][0], cacc[lt][1]); o.y = cvt_pk_bf16(cacc[lt][2], cacc[lt][3]);
                *(u32x2*)(lds + BN_OFF + (lt * 16 + fr) * XT_PITCH + (16 * wave + 4 * fq) * 2) = o; }
            __syncthreads();
        }
        const int i = wave >> 1, lh = wave & 1, head = su.g * 8 + su.hh * 4 + i;
        f32x4 y[4][4];
#pragma unroll
        for (int pt = 0; pt < 4; ++pt)
#pragma unroll
            for (int lt = 0; lt < 4; ++lt) y[pt][lt] = (f32x4){0.f, 0.f, 0.f, 0.f};
#pragma unroll 1
        for (int d = 0; d < 2; ++d) {
            int frd = fr, fqd = fq; asm volatile("" : "+v"(frd), "+v"(fqd));

            const float* QA = (const float*)(lds + QA_OFF) + (i * 2 + d) * 128; const float* DTA = (const float*)(lds + DTA_OFF) + (i * 2 + d) * 128;
            const bf16_t* Sp = nullptr;
            if (su.ctx) { const int b = su.cu >> 1; if ((d == 0 && su.c == 1) || (d == 1 && su.c == 0)) Sp = SINC + (size_t)((b * 16 + head) * 2 + d) * 8192; }
            else Sp = SINL + (size_t)(((su.cu - 32) * 16 + head) * 2 + d) * 8192;
            u32x4 Sf[4][4];
            if (Sp) {
#pragma unroll
                for (int pt = 0; pt < 4; ++pt)
#pragma unroll
                    for (int ks = 0; ks < 2; ++ks) Sf[pt][ks] = *(const u32x4*)((const char*)Sp + (unsigned)(((pt * 16 + frd) * 128 + ks * 32 + fqd * 8) * 2));
            }
#pragma unroll
            for (int lt = 0; lt < 4; ++lt) { const int l0 = 64 * lh + lt * 16, l = l0 + frd; const float ql = QA[l];
#pragma unroll
                for (int ks = 0; ks < 4; ++ks) {
                    const bool skip = (d == 0) ? (32 * ks > l0 + 15) : (32 * ks + 31 < l0);
                    if (!skip) {
                        const int s0i = ks * 32 + fqd * 8;
                        const u32x4 cr = *(const u32x4*)(lds + BN_OFF + l * XT_PITCH + s0i * 2);
                        const f32x4 da = *(const f32x4*)(DTA + s0i), db = *(const f32x4*)(DTA + s0i + 4);
                        float cv[8] = {bf_lo(cr.x), bf_hi(cr.x), bf_lo(cr.y), bf_hi(cr.y), bf_lo(cr.z), bf_hi(cr.z), bf_lo(cr.w), bf_hi(cr.w)};
                        float gsv[8] = {da[0], da[1], da[2], da[3], db[0], db[1], db[2], db[3]};
                        float pv[8];
#pragma unroll
                        for (int j = 0; j < 8; ++j) { const int s = s0i + j; const bool ok = (d == 0) ? (s <= l) : (s >= l);
                            pv[j] = ok ? cv[j] * __builtin_amdgcn_exp2f(ql - gsv[j]) : 0.f; }
                        u32x4 o; o.x = cvt_pk_bf16(pv[0], pv[1]); o.y = cvt_pk_bf16(pv[2], pv[3]); o.z = cvt_pk_bf16(pv[4], pv[5]); o.w = cvt_pk_bf16(pv[6], pv[7]);
                        const bf16x8 Pf = as_bf16x8(o);
#pragma unroll
                        for (int pt = 0; pt < 4; ++pt) { const int R = i * 64 + pt * 16 + frd, chunk = ks * 4 + fqd;
                            const bf16x8 Af = *(const bf16x8*)(lds + XT_OFF + R * XT_PITCH + ((chunk ^ ((R >> 3) & 3)) * 16));
                            y[pt][lt] = __builtin_amdgcn_mfma_f32_16x16x32_bf16(Af, Pf, y[pt][lt], 0, 0, 0); }
                    }
                } }
            if (Sp) {
#pragma unroll
                for (int pt = 0; pt < 4; ++pt)
#pragma unroll
                    for (int ks = 2; ks < 4; ++ks) Sf[pt][ks] = *(const u32x4*)((const char*)Sp + (unsigned)(((pt * 16 + frd) * 128 + ks * 32 + fqd * 8) * 2));
                float eq[4];
#pragma unroll
                for (int lt = 0; lt < 4; ++lt) eq[lt] = __builtin_amdgcn_exp2f(QA[64 * lh + lt * 16 + frd]);
#pragma unroll
                for (int ks = 0; ks < 4; ++ks) {
                    bf16x8 Bf[4];
#pragma unroll
                    for (int lt = 0; lt < 4; ++lt) { const int l = 64 * lh + lt * 16 + frd; const float e1 = eq[lt];
                        const u32x4 cr = *(const u32x4*)(lds + CN_OFF + l * XT_PITCH + (ks * 4 + fqd) * 16);
                        u32x4 o; o.x = cvt_pk_bf16(bf_lo(cr.x) * e1, bf_hi(cr.x) * e1); o.y = cvt_pk_bf16(bf_lo(cr.y) * e1, bf_hi(cr.y) * e1);
                        o.z = cvt_pk_bf16(bf_lo(cr.z) * e1, bf_hi(cr.z) * e1); o.w = cvt_pk_bf16(bf_lo(cr.w) * e1, bf_hi(cr.w) * e1);
                        Bf[lt] = as_bf16x8(o); }
#pragma unroll
                    for (int pt = 0; pt < 4; ++pt)
#pragma unroll
                        for (int lt = 0; lt < 4; ++lt) y[pt][lt] = __builtin_amdgcn_mfma_f32_16x16x32_bf16(as_bf16x8(Sf[pt][ks]), Bf[lt], y[pt][lt], 0, 0, 0);
                }
            }
        }
        { const float Dh = a.ssd_d[layer * 16 + head];
#pragma unroll
          for (int pt = 0; pt < 4; ++pt)
#pragma unroll
            for (int lt = 0; lt < 4; ++lt) { const int l = 64 * lh + lt * 16 + fr;
#pragma unroll
                for (int r = 0; r < 4; ++r) { const int R = i * 64 + pt * 16 + 4 * fq + r;
                    const unsigned short xv = *(const unsigned short*)(lds + XT_OFF + R * XT_PITCH + (((l >> 3) ^ ((R >> 3) & 3)) * 16) + (l & 7) * 2);
                    y[pt][lt][r] += Dh * __uint_as_float((unsigned)xv << 16); } } }
        const int cgz = tid & 31, rsub = tid >> 5; const int zc = (su.g * 8 + su.hh * 4) * 64 + cgz * 8;
        u32x4 zr[8];
#pragma unroll
        for (int ps = 0; ps < 8; ++ps) zr[ps] = __builtin_nontemporal_load((const u32x4*)((const char*)U + uoff((unsigned)(su.row0 + ps * 16 + rsub), (unsigned)(U_Z + zc))));
        __syncthreads();
        { float* YL = (float*)lds;
#pragma unroll
          for (int pt = 0; pt < 4; ++pt)
#pragma unroll
            for (int lt = 0; lt < 4; ++lt) { const int l = 64 * lh + lt * 16 + fr; *(f32x4*)(YL + l * YL_PITCH + i * 64 + pt * 16 + 4 * fq) = y[pt][lt]; } }
        __syncthreads();
        { const float* YL = (const float*)lds;
#pragma unroll
          for (int ps = 0; ps < 8; ++ps) { const int l = ps * 16 + rsub; const unsigned row = (unsigned)(su.row0 + l);
              const f32x4 y0 = *(const f32x4*)(YL + l * YL_PITCH + cgz * 8), y1 = *(const f32x4*)(YL + l * YL_PITCH + cgz * 8 + 4);
              const u32x4 z4 = zr[ps];
              float v[8] = {y0[0] * bf_lo(z4.x), y0[1] * bf_hi(z4.x), y0[2] * bf_lo(z4.y), y0[3] * bf_hi(z4.y),
                            y1[0] * bf_lo(z4.z), y1[1] * bf_hi(z4.z), y1[2] * bf_lo(z4.w), y1[3] * bf_hi(z4.w)};
              float ss = 0.f;
#pragma unroll
              for (int j = 0; j < 8; ++j) ss += v[j] * v[j];
              u32x4 o; o.x = cvt_pk_bf16(v[0], v[1]); o.y = cvt_pk_bf16(v[2], v[3]); o.z = cvt_pk_bf16(v[4], v[5]); o.w = cvt_pk_bf16(v[6], v[7]);
              *(u32x4*)((char*)YS + (row * 2048u + (unsigned)(zc * 2))) = o;
#pragma unroll
              for (int m = 1; m < 32; m <<= 1) ss += __shfl_xor(ss, m);
              if (cgz == 0) SSQ[(size_t)row * 4 + su.g * 2 + su.hh] = ss; } }
        __syncthreads();
    }
}

__device__ __forceinline__ void phaseConf(const Args& a, unsigned char* lds, int layer) {
    const int tid = ltid();
    const bf16_t* U = (const bf16_t*)(a.ws + WS_U); bf16_t* YC = (bf16_t*)(a.ws + WS_YC);
    const int c0 = 2 * tid; const unsigned voff = (unsigned)(c0 * 2);
    f32x2 w[31];
#pragma unroll
    for (int k = 0; k < 31; ++k) w[k] = *(const f32x2*)((const char*)a.conf_conv_w + ((unsigned)((layer * 31 + k) * 4096) + 2u * voff));
    const f32x2 cb2 = *(const f32x2*)((const char*)a.conf_conv_b + ((unsigned)(layer * 4096) + 2u * voff));
    const f32x2 lg = *(const f32x2*)((const char*)a.conf_ln_g + ((unsigned)(layer * 4096) + 2u * voff)), lb = *(const f32x2*)((const char*)a.conf_ln_b + ((unsigned)(layer * 4096) + 2u * voff));
#pragma unroll 1
    for (int u = vblock(); u < 512; u += gridDim.x) {
        int rbase, rstride, pos0, plen;
        if (u < 256) { const int b = u >> 4; pos0 = (u & 15) * 16; plen = 256; rbase = b * 256; rstride = 1; }
        else { const int v = u - 256, b = v >> 7, wc = (v >> 1) & 63; pos0 = (v & 1) * 16; plen = 32; rbase = NCTXTOK + b * 2048 + wc; rstride = 64; }
        unsigned ra[46], gs[16];
#pragma unroll
        for (int i = 0; i < 46; ++i) { ra[i] = 0u; const int pos = pos0 + i - 15;
            if (pos >= 0 && pos < plen) ra[i] = *(const unsigned*)((const char*)U + uoff((unsigned)(rbase + pos * rstride), (unsigned)(U_GA + c0))); }
#pragma unroll
        for (int o = 0; o < 16; ++o) gs[o] = __builtin_nontemporal_load((const unsigned*)((const char*)U + uoff((unsigned)(rbase + (pos0 + o) * rstride), (unsigned)(U_GS + c0))));
        f32x2 acc[16];
#pragma unroll
        for (int o = 0; o < 16; ++o) acc[o] = cb2;
#pragma unroll
        for (int i = 0; i < 46; ++i) { const f32x2 hh = (f32x2){bf_lo(ra[i]), bf_hi(ra[i])};
#pragma unroll
            for (int o = 0; o < 16; ++o) { const int k = i - o; if (k >= 0 && k < 31) acc[o] = __builtin_elementwise_fma(w[k], hh, acc[o]); } }
        float* red = (float*)lds;
#pragma unroll
        for (int o = 0; o < 16; ++o) { red[o * 512 + tid] = acc[o][0] + acc[o][1]; red[8192 + o * 512 + tid] = acc[o][0] * acc[o][0] + acc[o][1] * acc[o][1]; }
        __syncthreads();
        { const int o = tid >> 5, part = tid & 31; float s = 0.f, q = 0.f;
#pragma unroll
          for (int j = 0; j < 4; ++j) { const f32x4 t = *(const f32x4*)(red + o * 512 + part * 16 + j * 4), t2 = *(const f32x4*)(red + 8192 + o * 512 + part * 16 + j * 4);
              s += (t[0] + t[1]) + (t[2] + t[3]); q += (t2[0] + t2[1]) + (t2[2] + t2[3]); }
#pragma unroll
          for (int m = 1; m < 32; m <<= 1) { s += __shfl_xor(s, m); q += __shfl_xor(q, m); }
          __syncthreads();
          if (part == 0) { const float mean = s * (1.f / 1024.f); const float var = fmaxf(q * (1.f / 1024.f) - mean * mean, 0.f); red[2 * o] = mean; red[2 * o + 1] = rsqrtf(var + EPSF); } }
        __syncthreads();
#pragma unroll
        for (int o = 0; o < 16; ++o) { const unsigned row = (unsigned)(rbase + (pos0 + o) * rstride); const float mean = red[2 * o], rstd = red[2 * o + 1];
            const float v0 = silu_f((acc[o][0] - mean) * rstd * lg[0] + lb[0]) * bf_lo(gs[o]), v1 = silu_f((acc[o][1] - mean) * rstd * lg[1] + lb[1]) * bf_hi(gs[o]);
            *(unsigned*)((char*)YC + (row * 2048u + voff)) = cvt_pk_bf16(v0, v1); }
        __syncthreads();
    }
}

#define XB_TMO      128
#define XB_XCNT(j)  (256  + 64 * (j))
#define XB_XSUB(j)  (1280 + 64 * (j))
#define XB_XGEN(j)  (2304 + 64 * (j))
#define XB_TOP      3328
#define XB_TOPGEN   3392
#define XCD_BAR_WORDS 3456
#define XB_SPIN_CAP (1u << 18)
__device__ __forceinline__ unsigned xb_ld(unsigned* p)              { return __hip_atomic_load(p, __ATOMIC_RELAXED, __HIP_MEMORY_SCOPE_AGENT); }
__device__ __forceinline__ unsigned xb_add(unsigned* p, unsigned v) { return __hip_atomic_fetch_add(p, v, __ATOMIC_RELAXED, __HIP_MEMORY_SCOPE_AGENT); }
__device__ __forceinline__ unsigned xb_xcc_id() { return (unsigned)__builtin_amdgcn_s_getreg((3 << 11) | 20) & 0xFu; }
#define XB_SPIN(cond, bar) do { unsigned _sp = 0; while (cond) { __builtin_amdgcn_s_sleep(1); \
    if ((++_sp & 255u) == 0u) { if (xb_ld(&(bar)[XB_TMO])) break; if (_sp > XB_SPIN_CAP) { atomicAdd(&(bar)[XB_TMO], 1u); break; } } } } while (0)
struct XcdBarrier { unsigned* bar; unsigned x; volatile LAS unsigned* st; };
__device__ __forceinline__ XcdBarrier xcd_barrier_post(unsigned* bar, volatile LAS unsigned* st) {
    XcdBarrier b; b.bar = bar; b.x = xb_xcc_id(); b.st = st;
    if (threadIdx.x == 0) (void)xb_add(&bar[XB_XCNT(b.x)], 1u);
    return b;
}
__device__ __forceinline__ void xcd_barrier_complete(unsigned* bar, unsigned x, unsigned& nloc, unsigned& nx) {
    const unsigned G = gridDim.x * gridDim.y * gridDim.z;
    unsigned sum, cnt, mine, sp = 0u;
    for (;;) {
        sum = 0u; cnt = 0u; mine = 0u;
#pragma unroll
        for (unsigned j = 0; j < 16; ++j) { const unsigned c = xb_ld(&bar[XB_XCNT(j)]); sum += c; cnt += (c > 0u) ? 1u : 0u; mine = (j == x) ? c : mine; }
        if (sum == G) break;
        __builtin_amdgcn_s_sleep(1);
        if ((++sp & 255u) == 0u) { if (xb_ld(&bar[XB_TMO])) break; if (sp > XB_SPIN_CAP) { atomicAdd(&bar[XB_TMO], 1u); break; } }
    }
    nloc = mine > 0u ? mine : 1u; nx = cnt > 0u ? cnt : 1u;
}
__device__ __forceinline__ void xcd_barrier(const XcdBarrier& b) {
    asm volatile("s_waitcnt vmcnt(0)" ::: "memory");
    __syncthreads();
    if (threadIdx.x == 0) {
        unsigned* bar = b.bar;
        __builtin_amdgcn_s_waitcnt(0);
        unsigned nloc = b.st[0], nx = b.st[1];
        if (nloc == 0u) { xcd_barrier_complete(bar, b.x, nloc, nx); b.st[0] = nloc; b.st[1] = nx; }
        const unsigned old = xb_add(&bar[XB_XSUB(b.x)], 1u);
        const unsigned gen = old / nloc;
        if (old + 1u == (gen + 1u) * nloc) {
            __builtin_amdgcn_fence(__ATOMIC_RELEASE, "agent");
            asm volatile("s_waitcnt vmcnt(0)" ::: "memory");
            const unsigned og = xb_add(&bar[XB_TOP], 1u);
            const unsigned tg = og / nx;
            if (og + 1u == (tg + 1u) * nx) xb_add(&bar[XB_TOPGEN], 1u);
            else XB_SPIN(xb_ld(&bar[XB_TOPGEN]) == tg, bar);
            __builtin_amdgcn_fence(__ATOMIC_ACQUIRE, "agent");
            xb_add(&bar[XB_XGEN(b.x)], 1u);
            asm volatile("s_waitcnt vmcnt(0)" ::: "memory");
        } else {
            XB_SPIN(xb_ld(&bar[XB_XGEN(b.x)]) == gen, bar);
            __builtin_amdgcn_fence(__ATOMIC_ACQUIRE, "agent");
            asm volatile("s_waitcnt vmcnt(0)" ::: "memory");
        }
    }
    __syncthreads();
}
constexpr size_t WS_BAR = 768 * 1024;
constexpr int LDS_BARST = 151552;

typedef const __attribute__((address_space(4))) Args* ArgsP;
__device__ __forceinline__ const Args& fresh_args() { ArgsP p = (ArgsP)__builtin_amdgcn_kernarg_segment_ptr(); asm volatile("" : "+s"(p)); return *(const Args*)p; }
#define a (fresh_args())
#define GSYNC() do { for (int _r = 0; _r < REP_SYNC; ++_r) { XcdBarrier _b; _b.bar = (unsigned*)(a.ws + WS_BAR); _b.x = xb_xcc_id(); _b.st = (volatile LAS unsigned*)((LAS unsigned char*)lds + LDS_BARST); xcd_barrier(_b); } } while (0)
template <int layer>
__device__ __forceinline__ void layer_body(unsigned char* lds) {

#pragma unroll 1
        for (int rep = 0; rep < REP_GEMM; ++rep) {
            pg8::Gemm g{(const bf16_t*)(a.ws + WS_H), (const bf16_t*)(a.ws + WS_H), (const bf16_t*)(a.ws + WS_WIN + layer * WIN_BYTES), NTOK, NIN, 1024, 1 << 30};
            pg8::StaticOrder S; S.init(NTOK, NIN, (int)gridDim.x, (int)blockIdx.x);
            pg8::EpiIn E{(bf16_t*)(a.ws + WS_U), (float*)(a.ws + WS_DT)};
            pg8::gemm_phase<pg8::EpiIn, pg8::StaticOrder>((LAS unsigned char*)lds, g, S, E);
        }
        GSYNC();
#pragma unroll 1
        for (int rep = 0; rep < REP_SSD; ++rep) phaseB1(a, lds, layer);
#pragma unroll 1
        for (int rep = 0; rep < REP_MISC; ++rep) phaseConf(a, lds, layer);
        GSYNC();
        phaseScan(a, layer);
        GSYNC();
#pragma unroll 1
        for (int rep = 0; rep < REP_SSD; ++rep) phaseB3(a, lds, layer);
        GSYNC();
#pragma unroll 1
        for (int rep = 0; rep < REP_GEMM; ++rep) {
            pg8::Gemm g{(const bf16_t*)(a.ws + WS_YS), (const bf16_t*)(a.ws + WS_YC), (const bf16_t*)(a.ws + WS_WOUT + layer * WOUT_BYTES), NTOK, 2048, 1024, 4};
            pg8::StaticOrder S; S.init(NTOK, 2048, (int)gridDim.x, (int)blockIdx.x);
            pg8::EpiOut E{(bf16_t*)(a.ws + WS_OUT)};
            pg8::gemm_phase<pg8::EpiOut, pg8::StaticOrder>((LAS unsigned char*)lds, g, S, E);
        }
        GSYNC();
        phaseE(a, layer);
        if (layer == 0) GSYNC();
}
__global__ void __launch_bounds__(512, 2) fwd_megakernel(Args a_unused) {
    extern __shared__ __attribute__((aligned(16))) unsigned char lds[];
    cg::grid_group grid = cg::this_grid();
    if (a.ws == nullptr) grid.sync();
    if (threadIdx.x < 2) ((volatile LAS unsigned*)((LAS unsigned char*)lds + LDS_BARST))[threadIdx.x] = 0u;
    __syncthreads();
    (void)xcd_barrier_post((unsigned*)(a.ws + WS_BAR), (volatile LAS unsigned*)((LAS unsigned char*)lds + LDS_BARST));
    for (int rep = 0; rep < REP_MISC; ++rep) phase0(a, lds);
    GSYNC();
    for (int rep = 0; rep < REP_MISC; ++rep) phase1(a);
    GSYNC();
    layer_body<0>(lds);
    layer_body<1>(lds);
}
#undef a
extern "C" void kernel_launch(void* const* d_in, const int* in_sizes, int n_in, void* d_out, int out_size, void* d_ws, size_t ws_size, hipStream_t stream) {
    static int grid = 0;
    if (grid == 0) {
        int dev = 0, cus = 0, per_cu = 0;
        (void)hipGetDevice(&dev);
        (void)hipDeviceGetAttribute(&cus, hipDeviceAttributeMultiprocessorCount, dev);
        (void)hipFuncSetAttribute((const void*)fwd_megakernel, hipFuncAttributeMaxDynamicSharedMemorySize, LDS_BYTES);
        (void)hipOccupancyMaxActiveBlocksPerMultiprocessor(&per_cu, (const void*)fwd_megakernel, 512, LDS_BYTES);
        (void)hipGetLastError();
        if (per_cu < 1) fprintf(stderr, "kernel_launch: occupancy query reports %d blocks/CU\n", per_cu);
        grid = cus > 0 ? cus : 256;
    }
    Args a{};
    const float** f = (const float**)&a;
    for (int i = 0; i < 21; ++i) f[i] = (const float*)d_in[i];
    a.out = (float*)d_out; a.ws = (unsigned char*)d_ws;
    (void)hipMemsetAsync((unsigned char*)d_ws + WS_BAR, 0, XCD_BAR_WORDS * 4, stream);
    void* args[] = {&a};
    hipError_t e = hipLaunchCooperativeKernel((void*)fwd_megakernel, dim3(grid), dim3(512), args, LDS_BYTES, stream);
    if (e != hipSuccess) fprintf(stderr, "cooperative launch failed: %s (grid %d)\n", hipGetErrorString(e), grid);
}
```
